# Optimizing an MI355X kernel written in HIP

```python
import jax, jax.numpy as jnp
from jax import lax
import numpy as np

D_MODEL = 2048
BATCH = 16
SEQ = 2048
DEPTH = 4

N_BRANCH = 4
BRANCH_W = D_MODEL // 4
N_GROUPS = 4
GROUP_W = BRANCH_W // N_GROUPS
CHUNK = 128
SCONV_W = 3
N_HEADS = N_GROUPS
HEAD_DIM = GROUP_W
MOBA_BLOCK = 256
MOBA_TOPK = 3
Q_BLOCK = 128
ROPE_THETA = 10000.0
NEG = -1e30
LRU_CONV_W = 4
LRU_C = 8.0
D_FF = (((8 * D_MODEL + 2) // 3 + 255) // 256) * 256
EPS = 1e-6

A_OFF = 0
B_OFF = 2 * BRANCH_W
C_OFF = 5 * BRANCH_W
D_OFF = 8 * BRANCH_W
IN_W = 10 * BRANCH_W

kernel_name = "hybrid_gated_parallel_mixers"


def rmsnorm(x, g):
    xf = x.astype(jnp.float32)
    var = jnp.mean(xf * xf, axis=-1, keepdims=True)
    return (xf * lax.rsqrt(var + EPS)).astype(x.dtype) * g


def causal_depthwise_conv(x, w):
    K = w.shape[0]
    S = x.shape[1]
    xp = jnp.pad(x, ((0, 0), (K - 1, 0), (0, 0)))
    return sum(xp[:, k:k + S] * w[k] for k in range(K))


def rope(x, pos):
    half = x.shape[-1] // 2
    inv = ROPE_THETA ** (-jnp.arange(half, dtype=jnp.float32) / half)
    ang = pos.astype(jnp.float32)[:, None] * inv[None, :]
    cos = jnp.cos(ang)[None, :, None, :]
    sin = jnp.sin(ang)[None, :, None, :]
    xf = x.astype(jnp.float32)
    x1, x2 = xf[..., :half], xf[..., half:]
    return jnp.concatenate([x1 * cos - x2 * sin, x2 * cos + x1 * sin], axis=-1).astype(x.dtype)


def spatial_gating(u, v, w_s, b_s, g_v):
    Bn, S, _ = u.shape
    v = rmsnorm(v, g_v)
    mask = jnp.tril(jnp.ones((CHUNK, CHUNK), dtype=bool))
    w = jnp.where(mask[None], w_s, 0)
    vc = v.reshape(Bn, S // CHUNK, CHUNK, N_GROUPS, GROUP_W)
    mix = jnp.einsum('gts,bnsgc->bntgc', w, vc) + b_s[None, None, :, :, None]
    return u * mix.reshape(Bn, S, BRANCH_W)


def short_conv_mixer(b_gate, c_gate, xc, w_conv):
    return b_gate * causal_depthwise_conv(c_gate * xc, w_conv)


def moba_attention(q, k, v):
    Bn, S, H, Dh = q.shape
    nkb = -(-S // MOBA_BLOCK)
    pad = nkb * MOBA_BLOCK - S
    kp = jnp.pad(k, ((0, 0), (0, pad), (0, 0), (0, 0)))
    vp = jnp.pad(v, ((0, 0), (0, pad), (0, 0), (0, 0)))
    kb = kp.reshape(Bn, nkb, MOBA_BLOCK, H, Dh).transpose(0, 3, 1, 2, 4)
    vb = vp.reshape(Bn, nkb, MOBA_BLOCK, H, Dh).transpose(0, 3, 1, 2, 4)
    kmean = jnp.mean(kb.astype(jnp.float32), axis=3)
    own = jnp.arange(S) // MOBA_BLOCK
    gate = jnp.einsum('bshd,bhnd->bhsn', q.astype(jnp.float32), kmean)
    past = jnp.arange(nkb)[None, :] < own[:, None]
    gate = jnp.where(past[None, None], gate, NEG)
    topk = min(MOBA_TOPK, nkb)
    _, idx = lax.top_k(gate, topk)
    valid = idx < own[None, None, :, None]

    nqb = S // Q_BLOCK
    qs = q.reshape(Bn, nqb, Q_BLOCK, H, Dh).transpose(0, 1, 3, 2, 4).reshape(Bn * nqb, H, Q_BLOCK, Dh)
    idx_s = idx.reshape(Bn, H, nqb, Q_BLOCK, topk).transpose(0, 2, 1, 3, 4).reshape(Bn * nqb, H, Q_BLOCK, topk)
    val_s = valid.reshape(Bn, H, nqb, Q_BLOCK, topk).transpose(0, 2, 1, 3, 4).reshape(Bn * nqb, H, Q_BLOCK, topk)
    b_ids = jnp.repeat(jnp.arange(Bn), nqb)
    qb_ids = jnp.tile(jnp.arange(nqb), Bn)
    scale = Dh ** -0.5
    L = MOBA_BLOCK

    def one_block(args):
        qblk, idb, vld, b, qb = args
        kbb = kb[b]
        vbb = vb[b]
        kg = jax.vmap(lambda kh, ih: kh[ih])(kbb, idb)
        vg = jax.vmap(lambda vh, ih: vh[ih])(vbb, idb)
        s_sel = jnp.einsum('hqd,hqjld->hqjl', qblk, kg).astype(jnp.float32) * scale
        s_sel = jnp.where(vld[..., None], s_sel, NEG)
        qpos = qb * Q_BLOCK + jnp.arange(Q_BLOCK)
        own_blk = (qb * Q_BLOCK) // MOBA_BLOCK
        k_own = lax.dynamic_index_in_dim(kbb, own_blk, axis=1, keepdims=False)
        v_own = lax.dynamic_index_in_dim(vbb, own_blk, axis=1, keepdims=False)
        s_own = jnp.einsum('hqd,hld->hql', qblk, k_own).astype(jnp.float32) * scale
        kpos = own_blk * MOBA_BLOCK + jnp.arange(MOBA_BLOCK)
        s_own = jnp.where(kpos[None, None, :] <= qpos[None, :, None], s_own, NEG)
        s_all = jnp.concatenate([s_sel.reshape(H, Q_BLOCK, topk * L), s_own], axis=-1)
        p = jax.nn.softmax(s_all, axis=-1).astype(v.dtype)
        p_sel = p[..., :topk * L].reshape(H, Q_BLOCK, topk, L)
        p_own = p[..., topk * L:]
        return (jnp.einsum('hqjl,hqjld->hqd', p_sel, vg)
                + jnp.einsum('hql,hld->hqd', p_own, v_own))

    out = lax.map(one_block, (qs, idx_s, val_s, b_ids, qb_ids))
    return out.reshape(Bn, nqb, H, Q_BLOCK, Dh).transpose(0, 1, 3, 2, 4).reshape(Bn, S, H * Dh)


def rg_lru_mixer(xr, gate_in, conv_w, conv_b, w_a, b_a, w_x, b_x, lam):
    Bn, S, _ = xr.shape
    xr = causal_depthwise_conv(xr, conv_w) + conv_b
    xg = xr.reshape(Bn, S, N_GROUPS, GROUP_W)
    r = jax.nn.sigmoid(jnp.einsum('bsgi,gij->bsgj', xg, w_a).reshape(Bn, S, BRANCH_W) + b_a)
    i = jax.nn.sigmoid(jnp.einsum('bsgi,gij->bsgj', xg, w_x).reshape(Bn, S, BRANCH_W) + b_x)
    log_a = -LRU_C * r.astype(jnp.float32) * jax.nn.softplus(-lam.astype(jnp.float32))
    a = jnp.exp(log_a)
    bterm = jnp.sqrt(-jnp.expm1(2.0 * log_a)) * (i * xr).astype(jnp.float32)

    def comb(c1, c2):
        a1, b1 = c1
        a2, b2 = c2
        return a1 * a2, a2 * b1 + b2

    _, h = lax.associative_scan(comb, (a, bterm), axis=1)
    return jax.nn.gelu(gate_in) * h.astype(xr.dtype)


def setup_inputs(seed: int = 0) -> dict:
    key = jax.random.key(seed)
    ks = iter(jax.random.split(key, 32))

    def nrm(shape, scale):
        return jax.random.normal(next(ks), shape, jnp.float32) * scale

    def gain(shape):
        return 1.0 + 0.05 * jax.random.normal(next(ks), shape, jnp.float32)

    out_scale = (2 * DEPTH) ** -0.5
    x = jax.random.normal(next(ks), (BATCH, SEQ, D_MODEL), jnp.float32)
    u = jax.random.uniform(next(ks), (DEPTH, BRANCH_W), jnp.float32, 0.9, 0.999)
    a0 = u ** (1.0 / LRU_C)
    lru_lambda = jnp.log(a0) - jnp.log1p(-a0)
    return {
        "x": x,
        "g_mix": gain((DEPTH, D_MODEL)),
        "w_in": nrm((DEPTH, D_MODEL, IN_W), D_MODEL ** -0.5),
        "w_sgu": nrm((DEPTH, N_GROUPS, CHUNK, CHUNK), CHUNK ** -0.5),
        "b_sgu": gain((DEPTH, CHUNK, N_GROUPS)),
        "g_sgu": gain((DEPTH, BRANCH_W)),
        "w_sconv": nrm((DEPTH, SCONV_W, BRANCH_W), SCONV_W ** -0.5),
        "w_lru_conv": nrm((DEPTH, LRU_CONV_W, BRANCH_W), LRU_CONV_W ** -0.5),
        "b_lru_conv": nrm((DEPTH, BRANCH_W), 0.01),
        "w_lru_a": nrm((DEPTH, N_GROUPS, GROUP_W, GROUP_W), GROUP_W ** -0.5),
        "b_lru_a": nrm((DEPTH, BRANCH_W), 0.01),
        "w_lru_x": nrm((DEPTH, N_GROUPS, GROUP_W, GROUP_W), GROUP_W ** -0.5),
        "b_lru_x": nrm((DEPTH, BRANCH_W), 0.01),
        "lru_lambda": lru_lambda,
        "w_gate": nrm((DEPTH, N_BRANCH, D_MODEL, D_MODEL), D_MODEL ** -0.5),
        "b_gate": nrm((DEPTH, N_BRANCH, D_MODEL), 0.01),
        "w_branch": nrm((DEPTH, N_BRANCH, BRANCH_W, D_MODEL), BRANCH_W ** -0.5),
        "w_out": nrm((DEPTH, D_MODEL, D_MODEL), D_MODEL ** -0.5 * out_scale),
        "g_ffn": gain((DEPTH, D_MODEL)),
        "w_ffn1": nrm((DEPTH, D_MODEL, D_FF), D_MODEL ** -0.5),
        "w_ffn3": nrm((DEPTH, D_MODEL, D_FF), D_MODEL ** -0.5),
        "w_ffn2": nrm((DEPTH, D_FF, D_MODEL), D_FF ** -0.5 * out_scale),
        "g_final": gain((D_MODEL,)),
    }


def reference(x, g_mix, w_in, w_sgu, b_sgu, g_sgu, w_sconv, w_lru_conv, b_lru_conv,
              w_lru_a, b_lru_a, w_lru_x, b_lru_x, lru_lambda, w_gate, b_gate, w_branch,
              w_out, g_ffn, w_ffn1, w_ffn3, w_ffn2, g_final):
    Bn, S, _ = x.shape
    pos = jnp.arange(S)
    BW = BRANCH_W
    for l in range(DEPTH):
        xn = rmsnorm(x, g_mix[l])
        p = xn @ w_in[l]
        ua = jax.nn.gelu(p[..., A_OFF:A_OFF + BW])
        va = jax.nn.gelu(p[..., A_OFF + BW:A_OFF + 2 * BW])
        o_a = spatial_gating(ua, va, w_sgu[l], b_sgu[l], g_sgu[l])
        o_b = short_conv_mixer(p[..., B_OFF:B_OFF + BW], p[..., B_OFF + BW:B_OFF + 2 * BW],
                               p[..., B_OFF + 2 * BW:B_OFF + 3 * BW], w_sconv[l])
        q = rope(p[..., C_OFF:C_OFF + BW].reshape(Bn, S, N_HEADS, HEAD_DIM), pos)
        k = rope(p[..., C_OFF + BW:C_OFF + 2 * BW].reshape(Bn, S, N_HEADS, HEAD_DIM), pos)
        v = p[..., C_OFF + 2 * BW:C_OFF + 3 * BW].reshape(Bn, S, N_HEADS, HEAD_DIM)
        o_c = moba_attention(q, k, v)
        o_d = rg_lru_mixer(p[..., D_OFF:D_OFF + BW], p[..., D_OFF + BW:D_OFF + 2 * BW],
                           w_lru_conv[l], b_lru_conv[l], w_lru_a[l], b_lru_a[l],
                           w_lru_x[l], b_lru_x[l], lru_lambda[l])
        y = 0.0
        for bi, o in enumerate((o_a, o_b, o_c, o_d)):
            g = jax.nn.sigmoid(xn @ w_gate[l, bi] + b_gate[l, bi])
            y = y + g * (o @ w_branch[l, bi])
        x = x + y @ w_out[l]
        xn = rmsnorm(x, g_ffn[l])
        h = jax.nn.silu(xn @ w_ffn1[l]) * (xn @ w_ffn3[l])
        x = x + h @ w_ffn2[l]
    return rmsnorm(x, g_final)
```

```cpp
#include <hip/hip_runtime.h>
#include <cstdio>
#include <cstdint>
#include <type_traits>

#define GAS __attribute__((address_space(1)))
#define LAS __attribute__((address_space(3)))
typedef unsigned short bf16;
typedef short bf16x8 __attribute__((ext_vector_type(8)));
typedef short s16x4 __attribute__((ext_vector_type(4)));
typedef short v4i16_t __attribute__((ext_vector_type(4)));
typedef float f32x2 __attribute__((ext_vector_type(2)));
typedef float f32x4 __attribute__((ext_vector_type(4)));
typedef float f32x16 __attribute__((ext_vector_type(16)));
typedef unsigned u32x2 __attribute__((ext_vector_type(2)));
typedef unsigned u32x4 __attribute__((ext_vector_type(4)));

#ifndef MK_N_LAUNCHES
#define MK_N_LAUNCHES 1
#endif

constexpr int DM = 2048, NB = 16, SEQ = 2048, DEPTH = 4, MTOK = NB * SEQ, BW = 512, INW = 5120, DFF = 5632;
constexpr int NWAVES = 8, NTHR = 512;
constexpr float EPS = 1e-6f;
constexpr int NPHASE = 2 + 6 * DEPTH;

constexpr size_t MiB = 1u << 20;
constexpr size_t WS_CTL = 0, CTL_ZERO_BYTES = 1 * MiB;
constexpr size_t WS_W = 1 * MiB, W_LAYER = 134 * MiB;
constexpr size_t WO_IN = 0, WO_GB = 20 * MiB, WO_OUT = 60 * MiB, WO_13 = 68 * MiB, WO_2 = 112 * MiB;
constexpr size_t WS_SGUW = 537 * MiB, WS_LRUW = 538 * MiB, WS_ROPE = 539 * MiB;
constexpr size_t WS_SPLUS = WS_SGUW + 512 * 1024;
constexpr size_t WS_XB = 540 * MiB, WS_P = 668 * MiB, WS_O = 988 * MiB, WS_Y = 1116 * MiB, WS_RSA = 1244 * MiB, WS_RSB = 1245 * MiB, WS_XQS = 1246 * MiB, WS_MXA = 1247 * MiB, WS_MXB = 1248 * MiB, WS_END = 1249 * MiB;
constexpr size_t WS_H = WS_P;
constexpr size_t WS_SCR = WS_P;
constexpr size_t SCR_PER_CU = 256 * 1024;
static_assert((size_t)INW * DM * 2 <= WO_GB && WO_GB + (size_t)4 * DM * 3072 <= WO_OUT && WO_OUT + (size_t)DM * DM * 2 <= WO_13 &&
              WO_13 + (size_t)2 * DFF * DM * 2 <= WO_2 && WO_2 + (size_t)DM * DFF * 2 <= W_LAYER, "weight map");
static_assert(WS_W + DEPTH * W_LAYER <= WS_SGUW && WS_P + (size_t)MTOK * INW * 2 <= WS_O && WS_H + (size_t)MTOK * DFF * 2 <= WS_Y, "ws map");
constexpr int CW_WMAX = 131072;
constexpr int CW_CMAX = 65536;
constexpr int CW_BAR = 4096;

constexpr int RING_BYTES = 131072;
constexpr int LDS_BYTES = 163840;
constexpr int MISC_OFF = LDS_BYTES - 128;
constexpr int RED_OFF = MISC_OFF - 4096;
constexpr int SST_OFF = RED_OFF - 8192;
constexpr int YST_OFF = SST_OFF - 16384;
constexpr int PRO_SCR = 64 * 65 * 4;
static_assert(8 * PRO_SCR <= YST_OFF && YST_OFF >= RING_BYTES, "LDS map");

#define LDS_WAIT() asm volatile("s_waitcnt lgkmcnt(0)" ::: "memory")
#define VM_WAIT() asm volatile("s_waitcnt vmcnt(0)" ::: "memory")
#define SBAR() __builtin_amdgcn_sched_barrier(0)
#define LDS_BARRIER() do { asm volatile("s_waitcnt lgkmcnt(0)" ::: "memory"); __builtin_amdgcn_s_barrier(); asm volatile("" ::: "memory"); } while (0)

typedef __bf16 bf16x2_t __attribute__((ext_vector_type(2)));
__device__ __forceinline__ unsigned cvtpk(float lo, float hi) { const f32x2 v = {lo, hi}; const bf16x2_t b = __builtin_convertvector(v, bf16x2_t); return __builtin_bit_cast(unsigned, b); }
__device__ __forceinline__ float bf_lo(unsigned w) { return __uint_as_float(w << 16); }
__device__ __forceinline__ float bf_hi(unsigned w) { return __uint_as_float(w & 0xffff0000u); }
__device__ __forceinline__ float bf2f(bf16 b) { return __uint_as_float(((unsigned)b) << 16); }
__device__ __forceinline__ unsigned f2bf(float f) { unsigned u = __float_as_uint(f); return (u + 0x7fffu + ((u >> 16) & 1u)) >> 16; }
__device__ __forceinline__ float sigmoidf_(float x) { return __builtin_amdgcn_rcpf(1.0f + __expf(-x)); }
constexpr float LOG2E = 1.4426950408889634f;
__device__ __forceinline__ float sig255(float t) { return __builtin_amdgcn_rcpf(__builtin_amdgcn_exp2f(t) + (1.0f / 255.0f)); }
__device__ __forceinline__ float gelu_tanh(float x) { const float u = 0.7978845608028654f * (x + 0.044715f * x * x * x); return x * __builtin_amdgcn_rcpf(1.0f + __expf(-2.0f * u)); }
typedef int i32x4 __attribute__((ext_vector_type(4)));
typedef int i32x8 __attribute__((ext_vector_type(8)));
constexpr int XQP = 4096;
constexpr int GBP = 3072;
constexpr float XQ_CLIP = 1.05f;
__device__ __forceinline__ float xq_dx(float amax) { return (XQ_CLIP / 127.0f) * amax + 1e-20f; }
__device__ __forceinline__ float q8r(float v) { return __builtin_amdgcn_fmed3f(v, -127.f, 127.f) + 12582912.0f; }
__device__ __forceinline__ unsigned pack4_i8(float r0, float r1, float r2, float r3) {
    const unsigned p01 = __builtin_amdgcn_perm(__builtin_bit_cast(unsigned, r1), __builtin_bit_cast(unsigned, r0), 0x0c0c0400u);
    const unsigned p23 = __builtin_amdgcn_perm(__builtin_bit_cast(unsigned, r3), __builtin_bit_cast(unsigned, r2), 0x04000c0cu);
    return p01 | p23; }
__device__ __forceinline__ unsigned quant4_i8(float a, float b, float c, float d, float sx) { return pack4_i8(q8r(a * sx), q8r(b * sx), q8r(c * sx), q8r(d * sx)); }
__device__ __forceinline__ int opaque_tid() { int t = threadIdx.x; asm volatile("" : "+v"(t)); return t; }
template <class T> __device__ __forceinline__ T* opaque_ptr(T* p) { return p; }
__device__ __forceinline__ float shfl_idx(float v, int src) { return __builtin_bit_cast(float, __builtin_amdgcn_ds_bpermute(src << 2, __builtin_bit_cast(int, v))); }
__device__ __forceinline__ float shfl_x(float v, int m, int lane) { return shfl_idx(v, lane ^ m); }
__device__ __forceinline__ float shfl_up16(float v, int d, int lane) { return shfl_idx(v, ((lane & 15) >= d) ? lane - d : lane); }
__device__ __forceinline__ float wave_sum(float v, int lane) {
#pragma unroll
    for (int o = 1; o < 64; o <<= 1) v += shfl_x(v, o, lane);
    return v;
}

namespace pg8 {
constexpr int BM = 256, BK = 64, HALF = 128, HTB = HALF * BK * 2, STAGE_BYTES = 8 * HTB, NXCD = 8, WGM = 4;
__host__ __device__ __forceinline__ int lds_byte(int r, int c) { const int st = (r >> 4) * 2 + (c >> 5), rr = r & 15, cc = c & 31, ob = rr * 64 + cc * 2; return st * 1024 + (ob ^ (((ob >> 9) & 1) << 5)); }
__host__ __device__ __forceinline__ void stage_rc(int b, int& R, int& C) { const int st = b / 1024, sb = b % 1024, swz = sb ^ (((sb >> 9) & 1) << 5); R = (st >> 1) * 16 + swz / 64; C = (st & 1) * 32 + (swz % 64) / 2; }
__host__ __device__ __forceinline__ int perm32(int rho) { const int n = rho >> 4, i = rho & 15; return 8 * (i >> 2) + 4 * n + (i & 3); }

struct Unit { const char* A; const char* B; int nt, kind, pm, pn; };

template <int NM, int NN> struct TileOrder {
    static_assert(NM % WGM == 0 && (NM * NN) % NXCD == 0, "tile grid");
    int G, c;
    __device__ void init(int G_, int c_) { G = G_; c = c_; }
    __device__ __forceinline__ bool tile(int i, int& pm, int& pn) const {
        constexpr int nwg = NM * NN, q = nwg / NXCD, nig = WGM * NN;
        const int L = i * G + c; if (L >= nwg) return false;
        const int wgid = (L % NXCD) * q + L / NXCD;
        const int gid = wgid / nig, w = wgid % nig;
        pm = gid * WGM + (w % WGM); pn = w / WGM; return true;
    }
};
template <int NM, int NN> struct GemmSched {
    TileOrder<NM, NN> T; const char* A; const char* B; size_t tA, tB; int nt;
    __device__ __forceinline__ bool next(int i, Unit& u) const { int pm, pn; if (!T.tile(i, pm, pn)) return false;
        u.A = A + (size_t)pm * tA; u.B = B + (size_t)pn * tB; u.nt = nt; u.kind = 0; u.pm = pm; u.pn = pn; return true; }
};
struct GateSched {
    TileOrder<MTOK / 256, DM / 256> T; const char* XQ; const char* O; const char* Wgb;
    __device__ __forceinline__ bool next(int i, Unit& u) const { int pm, pn; if (!T.tile(i >> 3, pm, pn)) return false;
        const int seg = i & 7, k = seg >> 1, br = seg & 1;
        u.A = br ? O + ((size_t)pm * 256 * DM + (size_t)k * BW) * 2 : XQ + (size_t)pm * 256 * XQP;
        u.B = Wgb + (size_t)(k * DM + pn * 256) * GBP + (br ? 2048 : 0);
        u.nt = br ? 8 : 16; u.kind = seg; u.pm = pm; u.pn = pn; return true; }
};

template <class Epi, class Sched>
__device__ __forceinline__ void gemm_phase(LAS unsigned char* lds, const int lda, const int ldb, const Sched& S, const Epi& E) {
    const int tid = opaque_tid(), wid = __builtin_amdgcn_readfirstlane(tid >> 6), lane = tid & 63, wr = wid >> 2, wc = wid & 3, fr = lane & 15, fq = lane >> 4;
    unsigned voffA, voffB;
    { int R, C; stage_rc(tid * 16, R, C); const int Rb = Epi::PERM ? ((R & ~31) + perm32(R & 31)) : R;
        voffA = (unsigned)(R * lda + C) * 2u; voffB = (unsigned)(Rb * ldb + C) * 2u; }
    const size_t kstep = (size_t)(BK * 2);
    const size_t hstepA = (size_t)HALF * lda * 2, hstepB = (size_t)HALF * ldb * 2;
    const unsigned ldsw = (unsigned)wid * 1024u;
    const int aoff = lds_byte(wr * 64 + fr, fq * 8), boff = lds_byte(wc * 32 + fr, fq * 8);
#define PG8_SA(b, h) (((b) * 2 + (h)) * HTB)
#define PG8_SB(b, h) ((4 + (b) * 2 + (h)) * HTB)
#define PG8_STAGE(bufoff, gbase, voff, hstep) do { const char* g_ = (const char*)(gbase); asm volatile("" : "+s"(g_)); \
        __builtin_amdgcn_global_load_lds((const unsigned*)(g_ + (voff)), (LAS unsigned*)(lds + (bufoff) + ldsw), 16, 0, 0); \
        const char* h_ = g_ + ((hstep) >> 1); asm volatile("" : "+s"(h_));                   \
        __builtin_amdgcn_global_load_lds((const unsigned*)(h_ + (voff)), (LAS unsigned*)(lds + (bufoff) + ldsw + 8192), 16, 0, 0); } while (0)
#define PG8_LDA(dst, b, h) do { _Pragma("unroll") for (int m = 0; m < 4; ++m) _Pragma("unroll") for (int k = 0; k < 2; ++k) dst[m][k] = *(const LAS bf16x8*)(lds + PG8_SA(b, h) + aoff + m * 2048 + k * 1024); } while (0)
#define PG8_LDB(dst, b, h) do { _Pragma("unroll") for (int n = 0; n < 2; ++n) _Pragma("unroll") for (int k = 0; k < 2; ++k) dst[n][k] = *(const LAS bf16x8*)(lds + PG8_SB(b, h) + boff + n * 2048 + k * 1024); } while (0)
#define PG8_MMA(ai, bj, At, Bt) do { __builtin_amdgcn_s_setprio(1); _Pragma("unroll") for (int m = 0; m < 4; ++m) _Pragma("unroll") for (int n = 0; n < 2; ++n) _Pragma("unroll") for (int k = 0; k < 2; ++k) \
        acc[ai][bj][m][n] = __builtin_amdgcn_mfma_f32_16x16x32_bf16(Bt[n][k], At[m][k], acc[ai][bj][m][n], 0, 0, 0); __builtin_amdgcn_s_setprio(0); } while (0)
#define PG8_MMA8(ai, bj, At, Bt) do { __builtin_amdgcn_s_setprio(1); _Pragma("unroll") for (int m = 0; m < 4; ++m) _Pragma("unroll") for (int n = 0; n < 2; ++n) _Pragma("unroll") for (int k = 0; k < 2; ++k) \
        acc[ai][bj][m][n] = __builtin_bit_cast(f32x4, __builtin_amdgcn_mfma_i32_16x16x64_i8(__builtin_bit_cast(i32x4, Bt[n][k]), __builtin_bit_cast(i32x4, At[m][k]), __builtin_bit_cast(i32x4, acc[ai][bj][m][n]), 0, 0, 0)); __builtin_amdgcn_s_setprio(0); } while (0)
#define PG8_WAIT_V(n) asm volatile("s_waitcnt vmcnt(" #n ")" ::: "memory")
#define PG8_WAIT_L(n) asm volatile("s_waitcnt lgkmcnt(" #n ")" ::: "memory")
#define PG8_BAR __builtin_amdgcn_s_barrier()
#define PG8_SCHED __builtin_amdgcn_sched_barrier(0)
#define PG8_KLOOP(MMA) \
        for (int t = 0; t < nt; t += 2) { \
            const bool last = (t == nt - 2); \
            const char* a1 = cA + (size_t)(t + 1) * kstep; \
            const char* a2 = last ? nA : cA + (size_t)(t + 2) * kstep; const char* b2 = last ? nB : cB + (size_t)(t + 2) * kstep; \
            const char* a3 = a2 + kstep; const char* b3 = b2 + kstep; \
            PG8_LDB(B0, 0, 0); PG8_LDB(B1, 0, 1); PG8_SCHED; PG8_LDA(At, 0, 0); PG8_STAGE(PG8_SA(1, 1), a1 + hstepA, voffA, hstepA); \
            PG8_WAIT_V(8); PG8_WAIT_L(0); PG8_BAR; MMA(0, 0, At, B0); MMA(0, 1, At, B1); PG8_BAR; PG8_SCHED; \
            PG8_LDA(At, 0, 1); PG8_STAGE(PG8_SB(0, 0), b2, voffB, hstepB); PG8_STAGE(PG8_SB(0, 1), b2 + hstepB, voffB, hstepB); PG8_STAGE(PG8_SA(0, 0), a2, voffA, hstepA); \
            PG8_WAIT_V(8); PG8_WAIT_L(0); PG8_BAR; MMA(1, 0, At, B0); MMA(1, 1, At, B1); PG8_BAR; PG8_SCHED; \
            PG8_LDB(B0, 1, 0); PG8_LDB(B1, 1, 1); PG8_SCHED; PG8_LDA(At, 1, 0); PG8_STAGE(PG8_SA(0, 1), a2 + hstepA, voffA, hstepA); \
            PG8_WAIT_V(8); PG8_WAIT_L(0); PG8_BAR; MMA(0, 0, At, B0); MMA(0, 1, At, B1); PG8_BAR; PG8_SCHED; \
            PG8_LDA(At, 1, 1); PG8_STAGE(PG8_SB(1, 0), b3, voffB, hstepB); PG8_STAGE(PG8_SB(1, 1), b3 + hstepB, voffB, hstepB); PG8_STAGE(PG8_SA(1, 0), a3, voffA, hstepA); \
            PG8_WAIT_V(8); PG8_WAIT_L(0); PG8_BAR; MMA(1, 0, At, B0); MMA(1, 1, At, B1); PG8_BAR; PG8_SCHED; \
        }

    Unit cur, nxt; int ui = 0;
    if (!S.next(0, cur)) return;
    f32x4 acc[2][2][4][2];
    E.init(acc, cur, wr, wc, fr, fq);
    bf16x8 At[4][2], B0[2][2], B1[2][2];
    const char* cA = cur.A; const char* cB = cur.B;
    PG8_STAGE(PG8_SB(0, 0), cB, voffB, hstepB); PG8_STAGE(PG8_SB(0, 1), cB + hstepB, voffB, hstepB); PG8_STAGE(PG8_SA(0, 0), cA, voffA, hstepA); PG8_STAGE(PG8_SA(0, 1), cA + hstepA, voffA, hstepA);
    if (wr == 1) PG8_BAR;
    PG8_WAIT_V(2); PG8_BAR;
    PG8_STAGE(PG8_SB(1, 0), cB + kstep, voffB, hstepB); PG8_STAGE(PG8_SA(1, 0), cA + kstep, voffA, hstepA); PG8_STAGE(PG8_SB(1, 1), cB + hstepB + kstep, voffB, hstepB);
    PG8_WAIT_V(6); PG8_BAR;
    for (;;) {
        const bool has_next = S.next(ui + 1, nxt);
        const char* nA = has_next ? nxt.A : cA; const char* nB = has_next ? nxt.B : cB;
        const int nt = cur.nt;
        if constexpr (Epi::F8GATE) {
            if (!(cur.kind & 1)) { PG8_KLOOP(PG8_MMA8) if (wr == 0) PG8_BAR; E.template epi<0>(acc, cur, wr, wc); }
            else { PG8_KLOOP(PG8_MMA) if (wr == 0) PG8_BAR; E.template epi<1>(acc, cur, wr, wc); }
            if (!has_next) break; E.init(acc, nxt, wr, wc, fr, fq);
        } else {
        if constexpr (Epi::I8) { PG8_KLOOP(PG8_MMA8) } else { PG8_KLOOP(PG8_MMA) }
        if (wr == 0) PG8_BAR;
        if constexpr (Epi::FUSED_INIT) { E.epi_init(acc, cur, nxt, has_next, wr, wc, fr, fq); if (!has_next) break; }
        else { E(acc, cur, wr, wc, fr, fq); if (!has_next) break; E.init(acc, nxt, wr, wc, fr, fq); }
        }
        cur = nxt; cA = nA; cB = nB; ++ui;
        if (wr == 1) PG8_BAR;
    }
    PG8_WAIT_V(0);
    PG8_BAR;
#undef PG8_SA
#undef PG8_SB
#undef PG8_STAGE
#undef PG8_LDA
#undef PG8_LDB
#undef PG8_MMA
#undef PG8_MMA8
#undef PG8_KLOOP
#undef PG8_WAIT_V
#undef PG8_WAIT_L
#undef PG8_BAR
#undef PG8_SCHED
}

__device__ __forceinline__ float row_rstd(const float* rsp, int row) {
    const f32x4 a = *(const f32x4*)(rsp + (size_t)row * 8), b = *(const f32x4*)(rsp + (size_t)row * 8 + 4);
    const float ssum = ((a[0] + a[1]) + (a[2] + a[3])) + ((b[0] + b[1]) + (b[2] + b[3]));
    return 1.0f / sqrtf(ssum * (1.f / DM) + EPS);
}
__device__ __forceinline__ void rows_rstd(const float* rsp, int row0, float (&rs)[2][4]) {
    f32x4 a[2][4], b[2][4];
#pragma unroll
    for (int ai = 0; ai < 2; ++ai)
#pragma unroll
        for (int m = 0; m < 4; ++m) { const float* p = rsp + (size_t)(row0 + ai * HALF + m * 16) * 8; a[ai][m] = *(const f32x4*)p; b[ai][m] = *(const f32x4*)(p + 4); }
#pragma unroll
    for (int ai = 0; ai < 2; ++ai)
#pragma unroll
        for (int m = 0; m < 4; ++m) { const float ssum = ((a[ai][m][0] + a[ai][m][1]) + (a[ai][m][2] + a[ai][m][3])) + ((b[ai][m][0] + b[ai][m][1]) + (b[ai][m][2] + b[ai][m][3]));
            rs[ai][m] = __builtin_amdgcn_rsqf(ssum * (1.f / DM) + EPS); }
}
__device__ __forceinline__ void rows_sx(const float* rsq, float* xqs, int row0, bool rec, float (&sx)[2][4]) {
    f32x4 a[2][4], b[2][4];
#pragma unroll
    for (int ai = 0; ai < 2; ++ai)
#pragma unroll
        for (int m = 0; m < 4; ++m) { const float* p = rsq + (size_t)(row0 + ai * HALF + m * 16) * 8; a[ai][m] = *(const f32x4*)p; b[ai][m] = *(const f32x4*)(p + 4); }
#pragma unroll
    for (int ai = 0; ai < 2; ++ai)
#pragma unroll
        for (int m = 0; m < 4; ++m) { const float amax = fmaxf(fmaxf(fmaxf(a[ai][m][0], a[ai][m][1]), fmaxf(a[ai][m][2], a[ai][m][3])), fmaxf(fmaxf(b[ai][m][0], b[ai][m][1]), fmaxf(b[ai][m][2], b[ai][m][3])));
            const float dx = xq_dx(amax); sx[ai][m] = __builtin_amdgcn_rcpf(dx); if (rec) xqs[row0 + ai * HALF + m * 16] = dx; }
}
__device__ __forceinline__ void zero_acc(f32x4 (&acc)[2][2][4][2]) {
#pragma unroll
    for (int a = 0; a < 2; ++a)
#pragma unroll
        for (int b = 0; b < 2; ++b)
#pragma unroll
            for (int m = 0; m < 4; ++m)
#pragma unroll
                for (int n = 0; n < 2; ++n) acc[a][b][m][n] = (f32x4){0.f, 0.f, 0.f, 0.f};
}
struct EpiP {
    static constexpr bool PERM = true, FUSED_INIT = false, F8GATE = false, I8 = false;
    bf16* P; const float* cs; const float* rsp;
    __device__ __forceinline__ void init(f32x4 (&acc)[2][2][4][2], const Unit&, int, int, int, int) const { zero_acc(acc); }
    __device__ __forceinline__ void operator()(const f32x4 (&acc)[2][2][4][2], const Unit& u, int wr, int wc, int fr, int fq) const {
        const int row0 = u.pm * BM + wr * 64 + fr, col0 = u.pn * BM + wc * 32 + 8 * fq;
        const int mode = u.pn < 4 ? 1 : ((u.pn >= 10 && u.pn < 14) ? 2 : 0);
        float rsv[2][4]; rows_rstd(rsp, row0, rsv);
#pragma unroll
        for (int ai = 0; ai < 2; ++ai)
#pragma unroll
            for (int m = 0; m < 4; ++m) { const int row = row0 + ai * HALF + m * 16; bf16* rowp = P + (size_t)row * INW + col0;
                f32x4 c01 = (f32x4){1.f, 0.f, 1.f, 0.f}, c23 = c01;
                if (mode == 2) { const f32x4* t = (const f32x4*)(cs + ((size_t)(row & (SEQ - 1)) * 64 + wc * 16 + 4 * fq) * 2); c01 = t[0]; c23 = t[1]; }
                const float rs = rsv[ai][m];
#pragma unroll
                for (int bj = 0; bj < 2; ++bj) { f32x4 v0 = acc[ai][bj][m][0] * rs, v1 = acc[ai][bj][m][1] * rs;
                    if (mode == 1) {
#pragma unroll
                        for (int j = 0; j < 4; ++j) { v0[j] = gelu_tanh(v0[j]); v1[j] = gelu_tanh(v1[j]); } }
                    else if (mode == 2) {
                        const f32x4 a = v0, b = v1;
                        v0[0] = a[0] * c01[0] - a[1] * c01[1]; v0[1] = a[1] * c01[0] + a[0] * c01[1];
                        v0[2] = a[2] * c01[2] - a[3] * c01[3]; v0[3] = a[3] * c01[2] + a[2] * c01[3];
                        v1[0] = b[0] * c23[0] - b[1] * c23[1]; v1[1] = b[1] * c23[0] + b[0] * c23[1];
                        v1[2] = b[2] * c23[2] - b[3] * c23[3]; v1[3] = b[3] * c23[2] + b[2] * c23[3]; }
                    u32x4 w; w.x = cvtpk(v0[0], v0[1]); w.y = cvtpk(v0[2], v0[3]); w.z = cvtpk(v1[0], v1[1]); w.w = cvtpk(v1[2], v1[3]);
                    *(u32x4*)(rowp + bj * HALF) = w; } }
    }
};
struct EpiResBf {
    static constexpr bool PERM = true, FUSED_INIT = true, F8GATE = false, I8 = false;
    bf16* X; float* rsp; LAS float* red; unsigned char* XQ; const float* rsq; float* xqs; float* mxp; LAS float* redm;
    __device__ __forceinline__ void init(f32x4 (&acc)[2][2][4][2], const Unit& u, int wr, int wc, int fr, int fq) const {
        const int row0 = u.pm * BM + wr * 64 + fr, col0 = u.pn * BM + wc * 32 + 8 * fq;
#pragma unroll
        for (int ai = 0; ai < 2; ++ai)
#pragma unroll
            for (int m = 0; m < 4; ++m) { const bf16* rowp = X + (size_t)(row0 + ai * HALF + m * 16) * DM + col0;
#pragma unroll
                for (int bj = 0; bj < 2; ++bj) { const u32x4 w = *(const u32x4*)(rowp + bj * HALF);
                    acc[ai][bj][m][0] = (f32x4){bf_lo(w.x), bf_hi(w.x), bf_lo(w.y), bf_hi(w.y)}; acc[ai][bj][m][1] = (f32x4){bf_lo(w.z), bf_hi(w.z), bf_lo(w.w), bf_hi(w.w)}; } }
    }
    __device__ __forceinline__ void operator()(const f32x4 (&acc)[2][2][4][2], const Unit& u, int wr, int wc, int fr, int fq) const {
        const int row0 = u.pm * BM + wr * 64 + fr, col0 = u.pn * BM + wc * 32 + 8 * fq;
        float sxv[2][4] = {};
        if (XQ) rows_sx(rsq, xqs, row0, (fq == 0) && (wc == 0) && (u.pn == 0), sxv);
#pragma unroll
        for (int ai = 0; ai < 2; ++ai)
#pragma unroll
            for (int m = 0; m < 4; ++m) { bf16* rowp = X + (size_t)(row0 + ai * HALF + m * 16) * DM + col0; float sq = 0.f, am = 0.f;
#pragma unroll
                for (int bj = 0; bj < 2; ++bj) { const f32x4 v0 = acc[ai][bj][m][0], v1 = acc[ai][bj][m][1];
                    u32x4 w; w.x = cvtpk(v0[0], v0[1]); w.y = cvtpk(v0[2], v0[3]); w.z = cvtpk(v1[0], v1[1]); w.w = cvtpk(v1[2], v1[3]);
                    *(u32x4*)(rowp + bj * HALF) = w;
                    am = fmaxf(am, fmaxf(fmaxf(fmaxf(fabsf(v0[0]), fabsf(v0[1])), fmaxf(fabsf(v0[2]), fabsf(v0[3]))), fmaxf(fmaxf(fabsf(v1[0]), fabsf(v1[1])), fmaxf(fabsf(v1[2]), fabsf(v1[3])))));
                    if (XQ) { u32x2 q8; q8.x = quant4_i8(v0[0], v0[1], v0[2], v0[3], sxv[ai][m]); q8.y = quant4_i8(v1[0], v1[1], v1[2], v1[3], sxv[ai][m]);
                        *(u32x2*)(XQ + (size_t)(row0 + ai * HALF + m * 16) * XQP + col0 + bj * HALF) = q8; }
                    sq += (bf_lo(w.x) * bf_lo(w.x) + bf_hi(w.x) * bf_hi(w.x)) + (bf_lo(w.y) * bf_lo(w.y) + bf_hi(w.y) * bf_hi(w.y));
                    sq += (bf_lo(w.z) * bf_lo(w.z) + bf_hi(w.z) * bf_hi(w.z)) + (bf_lo(w.w) * bf_lo(w.w) + bf_hi(w.w) * bf_hi(w.w)); }
                { const int ln = fr | (fq << 4); sq += shfl_x(sq, 16, ln); sq += shfl_x(sq, 32, ln); am = fmaxf(am, shfl_x(am, 16, ln)); am = fmaxf(am, shfl_x(am, 32, ln)); }
                if (fq == 0) { red[(ai * HALF + wr * 64 + m * 16 + fr) * 4 + wc] = sq; redm[(ai * HALF + wr * 64 + m * 16 + fr) * 4 + wc] = am; } }
        asm volatile("s_waitcnt lgkmcnt(0)" ::: "memory"); __builtin_amdgcn_s_barrier(); asm volatile("" ::: "memory");
        const int t = opaque_tid();
        if (t < 256) { const f32x4 r4 = *(const LAS f32x4*)(red + t * 4); rsp[((size_t)u.pm * BM + t) * 8 + u.pn] = (r4[0] + r4[1]) + (r4[2] + r4[3]);
            const f32x4 m4 = *(const LAS f32x4*)(redm + t * 4); mxp[((size_t)u.pm * BM + t) * 8 + u.pn] = fmaxf(fmaxf(m4[0], m4[1]), fmaxf(m4[2], m4[3])); }
    }
    __device__ __forceinline__ void epi_init(f32x4 (&acc)[2][2][4][2], const Unit& u, const Unit& nx, bool has_next, int wr, int wc, int fr, int fq) const {
        const int row0 = u.pm * BM + wr * 64 + fr, col0 = u.pn * BM + wc * 32 + 8 * fq;
        const int nrow0 = nx.pm * BM + wr * 64 + fr, ncol0 = nx.pn * BM + wc * 32 + 8 * fq;
        float sxv[2][4] = {};
        if (XQ) rows_sx(rsq, xqs, row0, (fq == 0) && (wc == 0) && (u.pn == 0), sxv);
#pragma unroll
        for (int ai = 0; ai < 2; ++ai)
#pragma unroll
            for (int m = 0; m < 4; ++m) { bf16* rowp = X + (size_t)(row0 + ai * HALF + m * 16) * DM + col0; float sq = 0.f, am = 0.f;
#pragma unroll
                for (int bj = 0; bj < 2; ++bj) { const f32x4 v0 = acc[ai][bj][m][0], v1 = acc[ai][bj][m][1];
                    u32x4 w; w.x = cvtpk(v0[0], v0[1]); w.y = cvtpk(v0[2], v0[3]); w.z = cvtpk(v1[0], v1[1]); w.w = cvtpk(v1[2], v1[3]);
                    *(u32x4*)(rowp + bj * HALF) = w;
                    am = fmaxf(am, fmaxf(fmaxf(fmaxf(fabsf(v0[0]), fabsf(v0[1])), fmaxf(fabsf(v0[2]), fabsf(v0[3]))), fmaxf(fmaxf(fabsf(v1[0]), fabsf(v1[1])), fmaxf(fabsf(v1[2]), fabsf(v1[3])))));
                    if (XQ) { u32x2 q8; q8.x = quant4_i8(v0[0], v0[1], v0[2], v0[3], sxv[ai][m]); q8.y = quant4_i8(v1[0], v1[1], v1[2], v1[3], sxv[ai][m]);
                        *(u32x2*)(XQ + (size_t)(row0 + ai * HALF + m * 16) * XQP + col0 + bj * HALF) = q8; }
                    sq += (bf_lo(w.x) * bf_lo(w.x) + bf_hi(w.x) * bf_hi(w.x)) + (bf_lo(w.y) * bf_lo(w.y) + bf_hi(w.y) * bf_hi(w.y));
                    sq += (bf_lo(w.z) * bf_lo(w.z) + bf_hi(w.z) * bf_hi(w.z)) + (bf_lo(w.w) * bf_lo(w.w) + bf_hi(w.w) * bf_hi(w.w)); }
                { const int ln = fr | (fq << 4); sq += shfl_x(sq, 16, ln); sq += shfl_x(sq, 32, ln); am = fmaxf(am, shfl_x(am, 16, ln)); am = fmaxf(am, shfl_x(am, 32, ln)); }
                if (fq == 0) { red[(ai * HALF + wr * 64 + m * 16 + fr) * 4 + wc] = sq; redm[(ai * HALF + wr * 64 + m * 16 + fr) * 4 + wc] = am; }
                if (has_next) { const bf16* nrowp = X + (size_t)(nrow0 + ai * HALF + m * 16) * DM + ncol0;
#pragma unroll
                    for (int bj = 0; bj < 2; ++bj) { const u32x4 w = *(const u32x4*)(nrowp + bj * HALF);
                        acc[ai][bj][m][0] = (f32x4){bf_lo(w.x), bf_hi(w.x), bf_lo(w.y), bf_hi(w.y)}; acc[ai][bj][m][1] = (f32x4){bf_lo(w.z), bf_hi(w.z), bf_lo(w.w), bf_hi(w.w)}; } } }
        asm volatile("s_waitcnt lgkmcnt(0)" ::: "memory"); __builtin_amdgcn_s_barrier(); asm volatile("" ::: "memory");
        const int t = opaque_tid();
        if (t < 256) { const f32x4 r4 = *(const LAS f32x4*)(red + t * 4); rsp[((size_t)u.pm * BM + t) * 8 + u.pn] = (r4[0] + r4[1]) + (r4[2] + r4[3]);
            const f32x4 m4 = *(const LAS f32x4*)(redm + t * 4); mxp[((size_t)u.pm * BM + t) * 8 + u.pn] = fmaxf(fmaxf(m4[0], m4[1]), fmaxf(m4[2], m4[3])); }
    }
};
struct EpiSwiglu {
    static constexpr bool PERM = true, FUSED_INIT = false, F8GATE = false, I8 = true;
    bf16* H; const float* rsp; const float* xqs; const unsigned* cmax;
    __device__ __forceinline__ void init(f32x4 (&acc)[2][2][4][2], const Unit&, int, int, int, int) const { zero_acc(acc); }
    __device__ __forceinline__ void operator()(const f32x4 (&acc)[2][2][4][2], const Unit& u, int wr, int wc, int fr, int fq) const {
        const int row0 = u.pm * BM + wr * 64 + fr, col0 = u.pn * HALF + wc * 32 + 8 * fq;
        float dxv[2][4];
#pragma unroll
        for (int ai = 0; ai < 2; ++ai)
#pragma unroll
            for (int m = 0; m < 4; ++m) dxv[ai][m] = xqs[row0 + ai * HALF + m * 16];
        f32x4 d1[2], d3[2], nd1[2], id13[2];
#pragma unroll
        for (int n = 0; n < 2; ++n) { const u32x4 u1 = *(const u32x4*)(cmax + col0 + 4 * n), u3 = *(const u32x4*)(cmax + DFF + col0 + 4 * n);
#pragma unroll
            for (int j = 0; j < 4; ++j) { d1[n][j] = __builtin_bit_cast(float, u1[j]) * (1.0f / 127.0f); d3[n][j] = __builtin_bit_cast(float, u3[j]) * (1.0f / 127.0f);
                nd1[n][j] = d1[n][j] * (-LOG2E); id13[n][j] = __builtin_amdgcn_rcpf(d1[n][j] * d3[n][j]); } }
        float rsv[2][4]; rows_rstd(rsp, row0, rsv);
#pragma unroll
        for (int ai = 0; ai < 2; ++ai)
#pragma unroll
            for (int m = 0; m < 4; ++m) { const int row = row0 + ai * HALF + m * 16; bf16* rowp = H + (size_t)row * DFF + col0;
                const float ra = rsv[ai][m] * dxv[ai][m], ira2 = __builtin_amdgcn_rcpf(ra * ra);
                f32x4 h0, h1;
                const f32x4 av = __builtin_convertvector(__builtin_bit_cast(i32x4, acc[ai][0][m][0]), f32x4), bv = __builtin_convertvector(__builtin_bit_cast(i32x4, acc[ai][0][m][1]), f32x4);
                const f32x4 cav = __builtin_convertvector(__builtin_bit_cast(i32x4, acc[ai][1][m][0]), f32x4), cbv = __builtin_convertvector(__builtin_bit_cast(i32x4, acc[ai][1][m][1]), f32x4);
#pragma unroll
                for (int j = 0; j < 4; ++j) { const float a = av[j], b = bv[j], ca = cav[j], cb = cbv[j];
                    const float ea = __builtin_amdgcn_exp2f(a * (ra * nd1[0][j])), eb = __builtin_amdgcn_exp2f(b * (ra * nd1[1][j]));
                    const float ia = ira2 * id13[0][j], ib = ira2 * id13[1][j];
                    h0[j] = (a * ca) * __builtin_amdgcn_rcpf(__builtin_fmaf(ea, ia, ia)); h1[j] = (b * cb) * __builtin_amdgcn_rcpf(__builtin_fmaf(eb, ib, ib)); }
                u32x4 w; w.x = cvtpk(h0[0], h0[1]); w.y = cvtpk(h0[2], h0[3]); w.z = cvtpk(h1[0], h1[1]); w.w = cvtpk(h1[2], h1[3]);
                *(u32x4*)rowp = w; }
    }
};
struct EpiGate {
    static constexpr bool PERM = true, FUSED_INIT = false, F8GATE = true, I8 = false;
    bf16* Y; const float* bgate; char* scr; const float* rsp; LAS u32x4* sst; LAS u32x4* yst; const float* xqs; const unsigned* wmax;
#ifndef GATE_NG
#define GATE_NG 7
#endif
    static constexpr int NG = GATE_NG;
    static_assert(NG >= 7 && NG <= 8, "the LDS slot holds one row group per lane");
    mutable unsigned sq[4 * NG];
    __device__ __forceinline__ void init(f32x4 (&acc)[2][2][4][2], const Unit&, int, int, int, int) const { zero_acc(acc); }
    template <int BR>
    __device__ __forceinline__ void epi(const f32x4 (&acc)[2][2][4][2], const Unit& u, int wr, int wc) const {
        const int tid = opaque_tid(), seg = u.kind, k = seg >> 1, fr = tid & 15, fq = (tid >> 4) & 3;
        u32x4* Ya = (u32x4*)scr + tid; LAS u32x4* Sst = sst + tid;
        if constexpr (BR == 0) {
            const int bcol0 = u.pn * BM + wc * 32 + 8 * fq; f32x4 bv[2][2];
#pragma unroll
            for (int bj = 0; bj < 2; ++bj)
#pragma unroll
                for (int n = 0; n < 2; ++n) bv[bj][n] = *(const f32x4*)(bgate + k * DM + bcol0 + bj * HALF + 4 * n) * (-LOG2E) - 7.994353436858858f;
            float dxv[2][4];
#pragma unroll
            for (int ai = 0; ai < 2; ++ai)
#pragma unroll
                for (int m = 0; m < 4; ++m) dxv[ai][m] = xqs[u.pm * BM + wr * 64 + fr + ai * HALF + m * 16];
            const float dw = __builtin_bit_cast(float, __hip_atomic_load(wmax + k, __ATOMIC_RELAXED, __HIP_MEMORY_SCOPE_AGENT)) * (-LOG2E / 127.0f);
            float rsv[2][4]; rows_rstd(rsp, u.pm * BM + wr * 64 + fr, rsv);
            unsigned st1[4 * (8 - NG) + 4];
#pragma unroll
            for (int ai = 0; ai < 2; ++ai)
#pragma unroll
                for (int m = 0; m < 4; ++m) { const float rs = rsv[ai][m] * dxv[ai][m] * dw;
#pragma unroll
                    for (int bj = 0; bj < 2; ++bj) { const int j = (ai * 4 + m) * 2 + bj;
#pragma unroll
                        for (int n = 0; n < 2; ++n) { const f32x4 v = __builtin_convertvector(__builtin_bit_cast(i32x4, acc[ai][bj][m][n]), f32x4) * rs + bv[bj][n]; unsigned w = 0u;
                            w = __builtin_amdgcn_cvt_pk_u8_f32(sig255(v[0]), 0u, w); w = __builtin_amdgcn_cvt_pk_u8_f32(sig255(v[1]), 1u, w);
                            w = __builtin_amdgcn_cvt_pk_u8_f32(sig255(v[2]), 2u, w); w = __builtin_amdgcn_cvt_pk_u8_f32(sig255(v[3]), 3u, w);
                            if (ai * 4 + m < NG) sq[2 * j + n] = w; else st1[2 * j + n - 4 * NG] = w; } } }
#pragma unroll
            for (int c = 0; c < 8 - NG; ++c) Sst[c * NTHR] = (u32x4){st1[4 * c], st1[4 * c + 1], st1[4 * c + 2], st1[4 * c + 3]};
        } else {
            auto body = [&](auto KCt) { constexpr int KC = decltype(KCt)::value;
            const int row0 = u.pm * BM + wr * 64 + fr, col0 = u.pn * BM + wc * 32 + 8 * fq;
#pragma unroll
            for (int ai = 0; ai < 2; ++ai) {
                u32x4 yv[8]; u32x4 sv[4];
#pragma unroll
                for (int m = 0; m < 4; ++m) if (ai * 4 + m >= NG) sv[m] = Sst[(ai * 4 + m - NG) * NTHR];
                if constexpr (KC > 0) {
#pragma unroll
                    for (int q = 0; q < 8; ++q) yv[q] = (ai == 1 && q >= 6) ? yst[(q - 6) * NTHR + tid] : Ya[(ai * 8 + q) * NTHR]; }
#pragma unroll
                for (int m = 0; m < 4; ++m)
#pragma unroll
                    for (int bj = 0; bj < 2; ++bj) { const int q = m * 2 + bj, j = (ai * 4 + m) * 2 + bj; const unsigned s0 = (ai * 4 + m < NG) ? sq[2 * j] : sv[m][2 * bj], s1 = (ai * 4 + m < NG) ? sq[2 * j + 1] : sv[m][2 * bj + 1];
                        f32x4 z0, z1;
                        f32x4 y0 = (f32x4){0.f, 0.f, 0.f, 0.f}, y1 = y0;
                        if constexpr (KC > 0) { const u32x4 y = yv[q]; y0 = (f32x4){bf_lo(y.x), bf_hi(y.x), bf_lo(y.y), bf_hi(y.y)}; y1 = (f32x4){bf_lo(y.z), bf_hi(y.z), bf_lo(y.w), bf_hi(y.w)}; }
                        z0[0] = __builtin_fmaf((float)(s0 & 0xffu), acc[ai][bj][m][0][0], y0[0]); z0[1] = __builtin_fmaf((float)((s0 >> 8) & 0xffu), acc[ai][bj][m][0][1], y0[1]);
                        z0[2] = __builtin_fmaf((float)((s0 >> 16) & 0xffu), acc[ai][bj][m][0][2], y0[2]); z0[3] = __builtin_fmaf((float)(s0 >> 24), acc[ai][bj][m][0][3], y0[3]);
                        z1[0] = __builtin_fmaf((float)(s1 & 0xffu), acc[ai][bj][m][1][0], y1[0]); z1[1] = __builtin_fmaf((float)((s1 >> 8) & 0xffu), acc[ai][bj][m][1][1], y1[1]);
                        z1[2] = __builtin_fmaf((float)((s1 >> 16) & 0xffu), acc[ai][bj][m][1][2], y1[2]); z1[3] = __builtin_fmaf((float)(s1 >> 24), acc[ai][bj][m][1][3], y1[3]);
                        u32x4 w; w.x = cvtpk(z0[0], z0[1]); w.y = cvtpk(z0[2], z0[3]); w.z = cvtpk(z1[0], z1[1]); w.w = cvtpk(z1[2], z1[3]);
                        if constexpr (KC < 2) { if (ai == 1 && q >= 6) yst[(q - 6) * NTHR + tid] = w; else Ya[(ai * 8 + q) * NTHR] = w; }
                        else *(u32x4*)(Y + (size_t)(row0 + ai * HALF + m * 16) * DM + col0 + bj * HALF) = w; }
                asm volatile("" ::: "memory"); }
            };
            if (k == 0) body(std::integral_constant<int, 0>{}); else if (k == 3) body(std::integral_constant<int, 2>{}); else body(std::integral_constant<int, 1>{});
        }
    }
};
}

namespace att {
constexpr int D = 128, NW = 8, QBLK = 32, KVBLK = 64, QB = NW * QBLK;
constexpr int PQ = INW, PO = DM;
constexpr float SCALE = 0.08838834764831845f;
constexpr float THR = 8.f;
constexpr int SHM_V = KVBLK * D * 2, SHM_K = KVBLK * D * 2;
constexpr int OFF_WS = 2 * SHM_V + 2 * SHM_K;
constexpr int OFF_SEL = OFF_WS + NW * 64 * 4;
constexpr int OFF_KMEAN = OFF_SEL + 2 * 256 * 4;
constexpr int OFF_PART = OFF_KMEAN + 8 * 128 * 4;
#define KSWZ(row, colB) ((row) * 256 + ((colB) ^ (((row) & 7) << 4)))
__device__ __forceinline__ int v_st(int k, int c) { const int kk = (k & ~0xC) | ((k & 4) << 1) | ((k & 8) >> 1); return ((kk >> 3) * 4 + (c >> 5)) * 512 + ((kk & 7) * 32 + (c & 31)) * 2; }
__device__ __forceinline__ int v_rd_base(int lane) { return ((lane & 3) << 3) | (((lane >> 2) & 3) << 6) | (((lane >> 4) & 1) << 5) | (((lane >> 5) & 1) << 8); }
constexpr int v_rd_off(int d0, int ks, int half) { return d0 * 512 + ks * 4096 + half * 2048; }
__device__ __forceinline__ int crow(int r, int hi) { return (r & 3) + 8 * (r >> 2) + 4 * hi; }
__device__ __forceinline__ bf16x8 load8(const bf16* p) { return *reinterpret_cast<const bf16x8*>(p); }
__device__ __forceinline__ void mask_tile(f32x16& p0, f32x16& p1, int dq) {
    const float NEG = -__builtin_inff();
#pragma unroll
    for (int r = 0; r < 16; ++r) {
        const int c = (r & 3) + 8 * (r >> 2);
        if (dq - c < 0) p0[r] = NEG;
        if (dq - c - 32 < 0) p1[r] = NEG;
    }
}
__device__ __forceinline__ void partialSM(f32x16& p0, f32x16& p1, float& m_reg, float& mn, float& alpha) {
    float pmax = p0[0]; for (int r = 1; r < 16; ++r) pmax = fmaxf(pmax, p0[r]); for (int r = 0; r < 16; ++r) pmax = fmaxf(pmax, p1[r]);
    { auto rr = __builtin_amdgcn_permlane32_swap(__float_as_uint(pmax), __float_as_uint(pmax), false, false);
      pmax = fmaxf(__uint_as_float(rr[0]), __uint_as_float(rr[1])); }
    constexpr float C2 = 1.4426950408889634f * SCALE;
    if (__builtin_expect(__all((pmax - m_reg) * SCALE <= THR), 1)) { mn = m_reg; alpha = 1.f; }
    else { mn = fmaxf(m_reg, pmax); alpha = __builtin_amdgcn_exp2f((m_reg - mn) * C2); m_reg = mn; }
    const float mnL = -mn * C2;
    for (int r = 0; r < 16; ++r) p0[r] = fmaf(p0[r], C2, mnL); for (int r = 0; r < 16; ++r) p1[r] = fmaf(p1[r], C2, mnL);
    for (int r = 0; r < 16; ++r) p0[r] = __builtin_amdgcn_exp2f(p0[r]);
}
__device__ __forceinline__ void finishSM(f32x16& p0, f32x16& p1, float alpha, float& l_reg, bf16x8& pa0, bf16x8& pa1, bf16x8& pa2, bf16x8& pa3) {
    for (int r = 0; r < 16; ++r) p1[r] = __builtin_amdgcn_exp2f(p1[r]);
    float ps = 0; for (int r = 0; r < 16; ++r) ps += p0[r]; for (int r = 0; r < 16; ++r) ps += p1[r];
    { auto rr = __builtin_amdgcn_permlane32_swap(__float_as_uint(ps), __float_as_uint(ps), false, false);
      ps = __uint_as_float(rr[0]) + __uint_as_float(rr[1]); }
    l_reg = l_reg * alpha + ps;
#define PK4(P, B_, OUT) do { unsigned a0 = cvtpk(P[B_+0], P[B_+1]), a1 = cvtpk(P[B_+2], P[B_+3]);                          \
        unsigned b0 = cvtpk(P[B_+4], P[B_+5]), b1 = cvtpk(P[B_+6], P[B_+7]);                                             \
        auto r0 = __builtin_amdgcn_permlane32_swap(a0, b0, false, false); auto r1 = __builtin_amdgcn_permlane32_swap(a1, b1, false, false); \
        u32x4 w = {r0[0], r1[0], r0[1], r1[1]}; OUT = *reinterpret_cast<bf16x8*>(&w); } while (0)
    PK4(p0, 0, pa0); PK4(p0, 8, pa1); PK4(p1, 0, pa2); PK4(p1, 8, pa3);
#undef PK4
}
template <int KB>
__device__ __forceinline__ void qkt(f32x16& p0, f32x16& p1, const char* K_lds, int r32, int hi, const bf16x8* qr) {
    p0 = f32x16{}; p1 = f32x16{};
    const char* kb[4];
#pragma unroll
    for (int dd = 0; dd < 4; ++dd) kb[dd] = K_lds + KB * SHM_K + KSWZ(r32, (dd * 16 + hi * 8) * 2);
#pragma unroll
    for (int d0 = 0; d0 < 8; ++d0) { const char* a = kb[d0 & 3] + (d0 >> 2) * 128;
        bf16x8 b0 = *reinterpret_cast<const bf16x8*>(a);
        bf16x8 b1 = *reinterpret_cast<const bf16x8*>(a + 32 * 256);
        p0 = __builtin_amdgcn_mfma_f32_32x32x16_bf16(b0, qr[d0], p0, 0, 0, 0);
        p1 = __builtin_amdgcn_mfma_f32_32x32x16_bf16(b1, qr[d0], p1, 0, 0, 0); }
}
template <int VB>
__device__ __forceinline__ void pv_tile(f32x16* o, int vb0, bf16x8 pa0, bf16x8 pa1, bf16x8 pa2, bf16x8 pa3) {
#define TRRD(dst, off) asm volatile("ds_read_b64_tr_b16 %0, %1 offset:%2" : "=&v"(dst) : "v"(vb0), "i"(off) : "memory")
#define PV_D0(d0) do { s16x4 l0, l1, l2, l3, h0, h1, h2, h3; constexpr int b_ = VB * SHM_V + v_rd_off(d0, 0, 0); \
        TRRD(l0, b_); TRRD(h0, b_ + 2048); TRRD(l1, b_ + 4096); TRRD(h1, b_ + 6144); TRRD(l2, b_ + 8192); TRRD(h2, b_ + 10240); TRRD(l3, b_ + 12288); TRRD(h3, b_ + 14336); \
        asm volatile("s_waitcnt lgkmcnt(0)" ::: "memory"); SBAR();   \
        o[d0] = __builtin_amdgcn_mfma_f32_32x32x16_bf16(pa0, (bf16x8){l0[0], l0[1], l0[2], l0[3], h0[0], h0[1], h0[2], h0[3]}, o[d0], 0, 0, 0);   \
        o[d0] = __builtin_amdgcn_mfma_f32_32x32x16_bf16(pa1, (bf16x8){l1[0], l1[1], l1[2], l1[3], h1[0], h1[1], h1[2], h1[3]}, o[d0], 0, 0, 0);   \
        o[d0] = __builtin_amdgcn_mfma_f32_32x32x16_bf16(pa2, (bf16x8){l2[0], l2[1], l2[2], l2[3], h2[0], h2[1], h2[2], h2[3]}, o[d0], 0, 0, 0);   \
        o[d0] = __builtin_amdgcn_mfma_f32_32x32x16_bf16(pa3, (bf16x8){l3[0], l3[1], l3[2], l3[3], h3[0], h3[1], h3[2], h3[3]}, o[d0], 0, 0, 0); } while (0)
    PV_D0(0); PV_D0(1); PV_D0(2); PV_D0(3);
#undef PV_D0
#undef TRRD
}
struct Heads { const bf16* Q; const bf16* K; const bf16* V; bf16* O; };
struct BlockRef { int P0; int selix; };
struct Seam { bf16x8 qr[8]; bf16x8 st_v0, st_v1, st_k0, st_k1; };
#define ROW(p, k0, rr) ((p) + (size_t)((k0) + (rr)) * PQ + sc)
#define VMWN(n) asm volatile("s_waitcnt vmcnt(%0)" :: "i"(n) : "memory")
#define SLOAD_H(Kp, Vp, k0) do { S.st_v0 = load8(ROW(Vp, k0, sr)); S.st_v1 = load8(ROW(Vp, k0, 32 + sr));              \
                         S.st_k0 = load8(ROW(Kp, k0, sr)); S.st_k1 = load8(ROW(Kp, k0, 32 + sr)); } while (0)
#define SWRITE_HK(bf) do { *(bf16x8*)(K_lds + (bf) * SHM_K + kws) = S.st_k0; *(bf16x8*)(K_lds + (bf) * SHM_K + kws + 32 * 256) = S.st_k1; } while (0)
#define SWRITE_HV(bf) do { *(bf16x8*)(V_lds + (bf) * SHM_V + vst0) = S.st_v0; *(bf16x8*)(V_lds + (bf) * SHM_V + vst1) = S.st_v1; } while (0)
#define SWRITE_H(bf) do { SWRITE_HV(bf); SWRITE_HK(bf); } while (0)
__device__ __forceinline__ void moba_prime(const Heads& H, const BlockRef& cur, char* lds, Seam& S) {
    const int tid = opaque_tid(), wid = __builtin_amdgcn_readfirstlane(tid >> 6), lane = tid & 63, r32 = lane & 31, hi = lane >> 5;
    const int sr = tid >> 4, sc = (tid & 15) * 8, kws = KSWZ(sr, sc * 2); char* K_lds = lds + 2 * SHM_V;
    for (int d0 = 0; d0 < 8; ++d0) S.qr[d0] = load8(H.Q + (size_t)(cur.P0 + wid * QBLK + r32) * PQ + d0 * 16 + hi * 8);
    SLOAD_H(H.K, H.V, 0); VM_WAIT(); SWRITE_HK(0);
    __syncthreads();
}
__device__ __forceinline__ void moba_block(const Heads& H, const BlockRef& cur, const BlockRef& nxt, char* lds, Seam& S) {
    const int tid = opaque_tid(), wid = __builtin_amdgcn_readfirstlane(tid >> 6), lane = tid & 63, r32 = lane & 31, hi = lane >> 5;
    const int NT = (cur.P0 + QB) / KVBLK;
    const int qlo = cur.P0 + wid * QBLK, qm = qlo + r32 - 4 * hi;
    char* V_lds = lds; char* K_lds = lds + 2 * SHM_V;
    float* ws = (float*)(lds + OFF_WS) + wid * 64; float* li_l = ws, * al_l = ws + 32;
    const unsigned* selp = (const unsigned*)(lds + OFF_SEL) + cur.selix * 256 + wid * QBLK + r32;
    float m_reg = -1e30f, l_reg = 0; f32x16 o[4] = {};
    const int sr = tid >> 4, sc = (tid & 15) * 8, vst0 = v_st(sr, sc), vst1 = v_st(32 + sr, sc), kws = KSWZ(sr, sc * 2);
    const int vb0 = (int)(uintptr_t)V_lds + v_rd_base(lane);
    const bf16* Kh = H.K; const bf16* Vh = H.V;
#define RESC(a) do { if (__any((a) < 1.f)) { if (hi == 0) al_l[r32] = (a); asm volatile("s_waitcnt lgkmcnt(0)" ::: "memory");              \
                     for (int d_ = 0; d_ < 4; ++d_) for (int r = 0; r < 16; ++r) o[d_][r] *= al_l[crow(r, hi)]; } } while (0)
#define KBASE(t) ((t) * KVBLK)
#define MASKT(P0_, P1_, t) do { const int kb_ = KBASE(t); \
        if (kb_ < cur.P0) { if (!((*selp >> (kb_ >> 8)) & 1u)) { const float NEG_ = -__builtin_inff(); _Pragma("unroll") for (int r_ = 0; r_ < 16; ++r_) { P0_[r_] = NEG_; P1_[r_] = NEG_; } } } \
        else if (kb_ + KVBLK - 1 > qlo) mask_tile(P0_, P1_, qm - kb_); } while (0)
    constexpr int NQL = 8;
#define SEAM_K0() do { VMWN(NQL); SWRITE_HK(0); SBAR(); } while (0)
    f32x16 pA0, pA1, pB0, pB1; float mnA, mnB, alA, alB; bf16x8 pa0, pa1, pa2, pa3;
    SWRITE_HV(0); SBAR();
    if (NT > 1) { SLOAD_H(Kh, Vh, KBASE(1)); }
    SBAR(); qkt<0>(pA0, pA1, K_lds, r32, hi, S.qr);
    MASKT(pA0, pA1, 0); partialSM(pA0, pA1, m_reg, mnA, alA);
    if (NT > 1) { VM_WAIT(); SWRITE_H(1); }
    __syncthreads();
#define HALF_STEP(PX0, PX1, mnX, alX, PY0, PY1, alY, t, KB, VB, SB) do {                                                      \
        SBAR(); qkt<KB>(PX0, PX1, K_lds, r32, hi, S.qr);                                                          \
        finishSM(PY0, PY1, alY, l_reg, pa0, pa1, pa2, pa3); SBAR();                                                           \
        if ((t) + 1 < NT) { SLOAD_H(Kh, Vh, KBASE((t) + 1)); SBAR(); }                                               \
        pv_tile<VB>(o, vb0, pa0, pa1, pa2, pa3); MASKT(PX0, PX1, (t)); partialSM(PX0, PX1, m_reg, mnX, alX);                                        \
        __syncthreads();                                                                                                      \
        if ((t) + 1 < NT) { VM_WAIT(); SWRITE_H(SB); }                                                                          \
        RESC(alX); __syncthreads(); } while (0)
    for (int t = 1; t + 1 < NT; t += 2) {
        HALF_STEP(pB0, pB1, mnB, alB, pA0, pA1, alA, t, 1, 0, 0);
        HALF_STEP(pA0, pA1, mnA, alA, pB0, pB1, alB, t + 1, 0, 1, 1);
    }
    const bool even = (NT & 1) == 0;
    if (even) { SBAR(); qkt<1>(pB0, pB1, K_lds, r32, hi, S.qr); SBAR(); }
    SLOAD_H(Kh, Vh, 0); SBAR();
#pragma unroll
    for (int d0 = 0; d0 < 8; ++d0) S.qr[d0] = load8(H.Q + (size_t)(nxt.P0 + wid * QBLK + r32) * PQ + d0 * 16 + hi * 8);
    SBAR();
    finishSM(pA0, pA1, alA, l_reg, pa0, pa1, pa2, pa3); SBAR();
    pv_tile<0>(o, vb0, pa0, pa1, pa2, pa3);
    if (even) { MASKT(pB0, pB1, NT - 1); partialSM(pB0, pB1, m_reg, mnB, alB); __syncthreads(); RESC(alB);
        finishSM(pB0, pB1, alB, l_reg, pa0, pa1, pa2, pa3); SBAR(); pv_tile<1>(o, vb0, pa0, pa1, pa2, pa3); }
    SBAR(); SEAM_K0();
    if (hi == 0) li_l[r32] = l_reg; asm volatile("s_waitcnt lgkmcnt(0)" ::: "memory");
    float rli[16];
#pragma unroll
    for (int r = 0; r < 16; ++r) rli[r] = __builtin_amdgcn_rcpf(li_l[crow(r, hi)]);
    bf16* Ow = H.O + (size_t)(cur.P0 + wid * QBLK) * PO;
#pragma unroll
    for (int r = 0; r < 16; ++r) { const int orow = crow(r, hi);
#pragma unroll
        for (int d0 = 0; d0 < 4; ++d0) { const float v = o[d0][r] * rli[r];
            const float vn = shfl_x(v, 1, lane);
            if ((r32 & 1) == 0) *(unsigned*)(Ow + (size_t)orow * PO + d0 * 32 + r32) = cvtpk(v, vn); } }
    __syncthreads();
#undef RESC
#undef KBASE
#undef MASKT
#undef SEAM_K0
#undef HALF_STEP
}
#undef ROW
#undef VMWN
#undef SLOAD_H
#undef SWRITE_HK
#undef SWRITE_HV
#undef SWRITE_H
}

#define XB_TMO      128
#define XB_XCNT(j)  (256  + 64 * (j))
#define XB_XSUB(j)  (1280 + 64 * (j))
#define XB_XGEN(j)  (2304 + 64 * (j))
#define XB_TOP      3328
#define XB_TOPGEN   3392
#define XCD_BAR_WORDS 3456
#define XB_SPIN_CAP (1u << 18)
__device__ __forceinline__ unsigned xb_ld(unsigned* p)              { return __hip_atomic_load(p, __ATOMIC_RELAXED, __HIP_MEMORY_SCOPE_AGENT); }
__device__ __forceinline__ unsigned xb_add(unsigned* p, unsigned v) { return __hip_atomic_fetch_add(p, v, __ATOMIC_RELAXED, __HIP_MEMORY_SCOPE_AGENT); }
__device__ __forceinline__ unsigned xb_xcc_id() { return (unsigned)__builtin_amdgcn_s_getreg((3 << 11) | 20) & 0xFu; }
#define XB_SPIN(cond, bar) do { unsigned _sp = 0; while (cond) { __builtin_amdgcn_s_sleep(1); \
    if ((++_sp & 255u) == 0u) { if (xb_ld(&(bar)[XB_TMO])) break; if (_sp > XB_SPIN_CAP) { atomicAdd(&(bar)[XB_TMO], 1u); break; } } } } while (0)
struct XcdBarrier { unsigned* bar; unsigned x; volatile LAS unsigned* st; };
__device__ __forceinline__ XcdBarrier xcd_barrier_post(unsigned* bar, volatile LAS unsigned* st) {
    XcdBarrier b; b.bar = bar; b.x = xb_xcc_id(); b.st = st;
    if (threadIdx.x == 0) (void)xb_add(&bar[XB_XCNT(b.x)], 1u);
    return b;
}
__device__ __forceinline__ void xcd_barrier_complete(unsigned* bar, unsigned x, unsigned& nloc, unsigned& nx) {
    const unsigned G = gridDim.x * gridDim.y * gridDim.z;
    unsigned sum, cnt, mine, sp = 0u;
    for (;;) {
        sum = 0u; cnt = 0u; mine = 0u;
#pragma unroll
        for (unsigned j = 0; j < 16; ++j) { const unsigned c = xb_ld(&bar[XB_XCNT(j)]); sum += c; cnt += (c > 0u) ? 1u : 0u; mine = (j == x) ? c : mine; }
        if (sum == G) break;
        __builtin_amdgcn_s_sleep(1);
        if ((++sp & 255u) == 0u) { if (xb_ld(&bar[XB_TMO])) break; if (sp > XB_SPIN_CAP) { atomicAdd(&bar[XB_TMO], 1u); break; } }
    }
    nloc = mine > 0u ? mine : 1u; nx = cnt > 0u ? cnt : 1u;
}
__device__ __forceinline__ void xcd_barrier(const XcdBarrier& b) {
    asm volatile("s_waitcnt vmcnt(0)" ::: "memory");
    __syncthreads();
    if (threadIdx.x == 0) {
        unsigned* bar = b.bar;
        __builtin_amdgcn_s_waitcnt(0);
        unsigned nloc = b.st[0], nx = b.st[1];
        if (nloc == 0u) { xcd_barrier_complete(bar, b.x, nloc, nx); b.st[0] = nloc; b.st[1] = nx; }
        const unsigned old = xb_add(&bar[XB_XSUB(b.x)], 1u);
        const unsigned gen = old / nloc;
        if (old + 1u == (gen + 1u) * nloc) {
            __builtin_amdgcn_fence(__ATOMIC_RELEASE, "agent");
            asm volatile("s_waitcnt vmcnt(0)" ::: "memory");
            const unsigned og = xb_add(&bar[XB_TOP], 1u);
            const unsigned tg = og / nx;
            if (og + 1u == (tg + 1u) * nx) xb_add(&bar[XB_TOPGEN], 1u);
            else XB_SPIN(xb_ld(&bar[XB_TOPGEN]) == tg, bar);
            __builtin_amdgcn_fence(__ATOMIC_ACQUIRE, "agent");
            xb_add(&bar[XB_XGEN(b.x)], 1u);
            asm volatile("s_waitcnt vmcnt(0)" ::: "memory");
        } else {
            XB_SPIN(xb_ld(&bar[XB_XGEN(b.x)]) == gen, bar);
            __builtin_amdgcn_fence(__ATOMIC_ACQUIRE, "agent");
            asm volatile("s_waitcnt vmcnt(0)" ::: "memory");
        }
    }
    __syncthreads();
}

struct Args {
    const float* x; const float* g_mix; const float* w_in; const float* w_sgu; const float* b_sgu; const float* g_sgu; const float* w_sconv;
    const float* w_lru_conv; const float* b_lru_conv; const float* w_lru_a; const float* b_lru_a; const float* w_lru_x; const float* b_lru_x; const float* lru_lambda;
    const float* w_gate; const float* b_gate; const float* w_branch; const float* w_out; const float* g_ffn; const float* w_ffn1; const float* w_ffn3; const float* w_ffn2; const float* g_final;
    float* out; unsigned char* ws; int ph_lo, ph_hi, li, pad;
};
typedef const __attribute__((address_space(4))) Args* KA;
__device__ __forceinline__ KA opaque_ka(KA p) { asm volatile("" : "+s"(p)); return p; }

template <class RowMap>
__device__ __forceinline__ void transpose_item(const float* W, int ldw, bf16* dst, int ldd, int coff, const RowMap& rm, LAS float* scr, int k0, int n0, int lane, const float* gain = nullptr, const float scale = 1.0f) {
    const int rr = lane >> 4, c4 = (lane & 15) * 4;
    f32x4 v[16];
#pragma unroll
    for (int i = 0; i < 16; ++i) v[i] = *(const f32x4*)(W + (size_t)(k0 + 4 * i + rr) * ldw + n0 + c4);
#pragma unroll
    for (int i = 0; i < 16; ++i) { const int kk = 4 * i + rr; const float gk = (gain ? gain[k0 + kk] : 1.0f) * scale; LAS float* d = scr + kk * 65 + c4;
        d[0] = v[i][0] * gk; d[1] = v[i][1] * gk; d[2] = v[i][2] * gk; d[3] = v[i][3] * gk; }
    LDS_WAIT(); asm volatile("" ::: "memory");
    const int kc = (lane & 7) * 8;
#pragma unroll
    for (int j = 0; j < 8; ++j) { const int n = 8 * j + (lane >> 3); const LAS float* sp = scr + kc * 65 + n;
        u32x4 o; o.x = cvtpk(sp[0 * 65], sp[1 * 65]); o.y = cvtpk(sp[2 * 65], sp[3 * 65]); o.z = cvtpk(sp[4 * 65], sp[5 * 65]); o.w = cvtpk(sp[6 * 65], sp[7 * 65]);
        *(u32x4*)(dst + (size_t)rm(n0 + n) * ldd + coff + k0 + kc) = o; }
    LDS_WAIT(); asm volatile("" ::: "memory");
}
struct RmId { __device__ __forceinline__ int operator()(int n) const { return n; } };
struct RmIn { __device__ __forceinline__ int operator()(int n) const { if (n < 2560 || n >= 3584) return n; const int d = n & 127; return (n & ~127) + 2 * (d & 63) + (d >> 6); } };
struct Rm13 { int half; __device__ __forceinline__ int operator()(int n) const { return (n >> 7) * 256 + half * 128 + (n & 127); } };
template <class RowMap>
__device__ __forceinline__ void transpose_item_i8(const float* W, int ldw, unsigned char* dst, int pitch, const RowMap& rm, LAS float* scr, int k0, int n0, int lane, const float* gain, const float sw, const unsigned* colmax = nullptr) {
    const int rr = lane >> 4, c4 = (lane & 15) * 4;
    f32x4 v[16];
#pragma unroll
    for (int i = 0; i < 16; ++i) v[i] = *(const f32x4*)(W + (size_t)(k0 + 4 * i + rr) * ldw + n0 + c4);
    f32x4 sc = (f32x4){sw, sw, sw, sw};
    if (colmax) {
#pragma unroll
        for (int c = 0; c < 4; ++c) sc[c] = 127.0f / __builtin_bit_cast(float, __hip_atomic_load(colmax + n0 + c4 + c, __ATOMIC_RELAXED, __HIP_MEMORY_SCOPE_AGENT)); }
#pragma unroll
    for (int i = 0; i < 16; ++i) { const int kk = 4 * i + rr; const float gk = gain[k0 + kk]; LAS float* d = scr + kk * 65 + c4;
        d[0] = v[i][0] * gk * sc[0]; d[1] = v[i][1] * gk * sc[1]; d[2] = v[i][2] * gk * sc[2]; d[3] = v[i][3] * gk * sc[3]; }
    LDS_WAIT(); asm volatile("" ::: "memory");
    const int kc = (lane & 7) * 8;
#pragma unroll
    for (int j = 0; j < 8; ++j) { const int n = 8 * j + (lane >> 3); const LAS float* sp = scr + kc * 65 + n;
        u32x2 o; o.x = quant4_i8(sp[0 * 65], sp[1 * 65], sp[2 * 65], sp[3 * 65], 1.0f); o.y = quant4_i8(sp[4 * 65], sp[5 * 65], sp[6 * 65], sp[7 * 65], 1.0f);
        *(u32x2*)(dst + (size_t)rm(n0 + n) * pitch + k0 + kc) = o; }
    LDS_WAIT(); asm volatile("" ::: "memory");
}

__device__ __forceinline__ void wmax_phase(KA a, int vcu, int NGW, const int L) {
    const int tid = opaque_tid(), lane = tid & 63, gw = vcu * NWAVES + __builtin_amdgcn_readfirstlane(tid >> 6);
    unsigned* wm = (unsigned*)(a->ws + WS_CTL) + CW_WMAX;
    constexpr int I_G = (DM / 64) * (DM / 64);
    for (int it = gw; it < 4 * I_G; it += NGW) {
        const int lk = L * 4 + it / I_G, r = it % I_G, k0 = 64 * (r / (DM / 64)), n0 = 64 * (r % (DM / 64)), rr = lane >> 4, c4 = (lane & 15) * 4;
        const float* W = a->w_gate + (size_t)lk * DM * DM; const float* g = a->g_mix + (lk >> 2) * DM;
        f32x4 v[16];
#pragma unroll
        for (int i = 0; i < 16; ++i) v[i] = *(const f32x4*)(W + (size_t)(k0 + 4 * i + rr) * DM + n0 + c4);
        float mx = 0.f;
#pragma unroll
        for (int i = 0; i < 16; ++i) { const float gk = g[k0 + 4 * i + rr];
            mx = fmaxf(mx, fmaxf(fmaxf(fabsf(v[i][0] * gk), fabsf(v[i][1] * gk)), fmaxf(fabsf(v[i][2] * gk), fabsf(v[i][3] * gk)))); }
#pragma unroll
        for (int o = 1; o < 64; o <<= 1) mx = fmaxf(mx, shfl_x(mx, o, lane));
        if (lane == 0) atomicMax(wm + lk, __builtin_bit_cast(unsigned, mx));
    }
    constexpr int I_1 = (DM / 64) * (DFF / 64);
    unsigned* cm = (unsigned*)(a->ws + WS_CTL) + CW_CMAX;
    for (int it = gw; it < 2 * I_1; it += NGW) {
        const int lh = L * 2 + it / I_1, r = it % I_1, l = L, k0 = 64 * (r / (DFF / 64)), n0 = 64 * (r % (DFF / 64)), rr = lane >> 4, c4 = (lane & 15) * 4;
        const float* W = ((lh & 1) ? a->w_ffn3 : a->w_ffn1) + (size_t)l * DM * DFF; const float* g = a->g_ffn + l * DM;
        f32x4 v[16];
#pragma unroll
        for (int i = 0; i < 16; ++i) v[i] = *(const f32x4*)(W + (size_t)(k0 + 4 * i + rr) * DFF + n0 + c4);
        f32x4 mx = (f32x4){0.f, 0.f, 0.f, 0.f};
#pragma unroll
        for (int i = 0; i < 16; ++i) { const float gk = g[k0 + 4 * i + rr];
            mx[0] = fmaxf(mx[0], fabsf(v[i][0] * gk)); mx[1] = fmaxf(mx[1], fabsf(v[i][1] * gk)); mx[2] = fmaxf(mx[2], fabsf(v[i][2] * gk)); mx[3] = fmaxf(mx[3], fabsf(v[i][3] * gk)); }
#pragma unroll
        for (int c = 0; c < 4; ++c) { mx[c] = fmaxf(mx[c], shfl_x(mx[c], 16, lane)); mx[c] = fmaxf(mx[c], shfl_x(mx[c], 32, lane)); }
        if (lane < 16) {
#pragma unroll
            for (int c = 0; c < 4; ++c) atomicMax(cm + (size_t)lh * DFF + n0 + c4 + c, __builtin_bit_cast(unsigned, mx[c])); }
    }
}
__device__ __forceinline__ void prologue_phase(KA a, LAS unsigned char* lds, int vcu, int NGW, const int part, const int L) {
    const int tid = opaque_tid(), lane = tid & 63, wave = __builtin_amdgcn_readfirstlane(tid >> 6), gw = vcu * NWAVES + wave;
    LAS float* scr = (LAS float*)(lds + wave * PRO_SCR);
    constexpr int I_IN = (DM / 64) * (INW / 64), I_G = (DM / 64) * (DM / 64), I_B = (BW / 64) * (DM / 64), I_O = (DM / 64) * (DM / 64), I_1 = (DM / 64) * (DFF / 64), I_2 = (DFF / 64) * (DM / 64);
    constexpr int I_LAYER = I_IN + 4 * I_G + 4 * I_B + I_O + 2 * I_1 + I_2;
    if (part == 1) {
        const int l = L; unsigned char* wl = a->ws + WS_W + (size_t)l * W_LAYER;
        for (int it = gw; it < 4 * I_G + 2 * I_1; it += NGW) { int r = it;
        if (r < 4 * I_G) { const int k = r / I_G; r -= k * I_G; const int nb = DM / 64;
            const float sw = 127.0f / __builtin_bit_cast(float, __hip_atomic_load((const unsigned*)(a->ws + WS_CTL) + CW_WMAX + l * 4 + k, __ATOMIC_RELAXED, __HIP_MEMORY_SCOPE_AGENT));
            transpose_item_i8(a->w_gate + ((size_t)l * 4 + k) * DM * DM, DM, wl + WO_GB + (size_t)k * DM * GBP, GBP, RmId{}, scr, 64 * (r / nb), 64 * (r % nb), lane, a->g_mix + l * DM, sw); continue; } r -= 4 * I_G;
        if (r < 2 * I_1) { const int hf = r / I_1; r -= hf * I_1; const int nb = DFF / 64;
            transpose_item_i8((hf ? a->w_ffn3 : a->w_ffn1) + (size_t)l * DM * DFF, DFF, wl + WO_13, DM, Rm13{hf}, scr, 64 * (r / nb), 64 * (r % nb), lane, a->g_ffn + l * DM, 0.f, (const unsigned*)(a->ws + WS_CTL) + CW_CMAX + (size_t)(2 * l + hf) * DFF); continue; }
        }
        return; }
    if (part == 2) { for (int it = gw; it < DEPTH * I_LAYER; it += NGW) {
        const int l = it / I_LAYER; int r = it - l * I_LAYER;
        unsigned char* wl = a->ws + WS_W + (size_t)l * W_LAYER;
        if (r < I_IN) { const int nb = INW / 64; transpose_item(a->w_in + (size_t)l * DM * INW, INW, (bf16*)(wl + WO_IN), DM, 0, RmIn{}, scr, 64 * (r / nb), 64 * (r % nb), lane, a->g_mix + l * DM); continue; } r -= I_IN;
        if (r < 4 * I_G) continue; r -= 4 * I_G;
        if (r < 4 * I_B) { const int k = r / I_B; r -= k * I_B; const int nb = DM / 64;
            transpose_item(a->w_branch + ((size_t)l * 4 + k) * BW * DM, DM, (bf16*)(wl + WO_GB + (size_t)k * DM * GBP), GBP / 2, 1024, RmId{}, scr, 64 * (r / nb), 64 * (r % nb), lane, nullptr, 1.0f / 255.0f); continue; } r -= 4 * I_B;
        if (r < I_O) { const int nb = DM / 64; transpose_item(a->w_out + (size_t)l * DM * DM, DM, (bf16*)(wl + WO_OUT), DM, 0, RmId{}, scr, 64 * (r / nb), 64 * (r % nb), lane); continue; } r -= I_O;
        if (r < 2 * I_1) continue; r -= 2 * I_1;
        { const int nb = DM / 64; transpose_item(a->w_ffn2 + (size_t)l * DFF * DM, DM, (bf16*)(wl + WO_2), DFF, 0, RmId{}, scr, 64 * (r / nb), 64 * (r % nb), lane); }
    }
    return; }
    { bf16* xb = (bf16*)(a->ws + WS_XB); float* rsa = (float*)(a->ws + WS_RSA); unsigned char* xq = (unsigned char*)a->out; float* xqs = (float*)(a->ws + WS_XQS); float* mxa = (float*)(a->ws + WS_MXA);
      for (int m = gw; m < MTOK; m += NGW) {
          const f32x4* xr = (const f32x4*)(a->x + (size_t)m * DM) + lane; u32x2* o8 = (u32x2*)(xb + (size_t)m * DM) + lane; float sq = 0.f;
          f32x4 v[8];
#pragma unroll
          for (int j = 0; j < 8; ++j) v[j] = xr[64 * j];
#pragma unroll
          for (int j = 0; j < 8; ++j) { u32x2 w; w.x = cvtpk(v[j].x, v[j].y); w.y = cvtpk(v[j].z, v[j].w); o8[64 * j] = w;
              sq += (bf_lo(w.x) * bf_lo(w.x) + bf_hi(w.x) * bf_hi(w.x)) + (bf_lo(w.y) * bf_lo(w.y) + bf_hi(w.y) * bf_hi(w.y)); }
          sq = wave_sum(sq, lane); if (lane < 8) rsa[(size_t)m * 8 + lane] = (lane == 0) ? sq : 0.f;
          float am = 0.f;
#pragma unroll
          for (int j = 0; j < 8; ++j) am = fmaxf(am, fmaxf(fmaxf(fabsf(v[j].x), fabsf(v[j].y)), fmaxf(fabsf(v[j].z), fabsf(v[j].w))));
#pragma unroll
          for (int o = 1; o < 64; o <<= 1) am = fmaxf(am, shfl_x(am, o, lane));
          if (lane < 8) mxa[(size_t)m * 8 + lane] = (lane == 0) ? am : 0.f;
          const float dx = xq_dx(am), sx = __builtin_amdgcn_rcpf(dx); if (lane == 0) xqs[m] = dx;
#pragma unroll
          for (int j = 0; j < 8; ++j) *(unsigned*)(xq + (size_t)m * XQP + (lane + 64 * j) * 4) = quant4_i8(v[j].x, v[j].y, v[j].z, v[j].w, sx); } }
    const int gt = gw * 64 + lane, NGT = NGW * 64;
    bf16* sg = (bf16*)(a->ws + WS_SGUW);
    for (int i = gt; i < DEPTH * 4 * 128 * 128; i += NGT) { const int s = i & 127, t = (i >> 7) & 127; sg[i] = (bf16)(s <= t ? f2bf(a->w_sgu[i]) : 0u); }
    bf16* lw = (bf16*)(a->ws + WS_LRUW);
    for (int i = gt; i < DEPTH * 4 * 4 * 64 * 128; i += NGT) { const int ch = i & 127, n = (i >> 7) & 63, q4 = (i >> 13) & 3, lg = i >> 15;
        const float* src = (n < 32) ? a->w_lru_a : a->w_lru_x; lw[i] = (bf16)f2bf(src[((size_t)lg * 128 + ch) * 128 + q4 * 32 + (n & 31)]); }
    float* spl = (float*)(a->ws + WS_SPLUS);
    for (int i = gt; i < DEPTH * BW; i += NGT) { const float lam = a->lru_lambda[i]; spl[i] = (lam > 15.f) ? expf(-lam) : ((lam < -15.f) ? -lam : log1pf(expf(-lam))); }
    float* cs = (float*)(a->ws + WS_ROPE);
    for (int i = gt; i < SEQ * 64; i += NGT) { const int fi = i & 63, pos = i >> 6;
        const float inv = (float)exp(-(double)fi * (9.210340371976184 / 64.0));
        const double ang = (double)((float)pos * inv);
        const double kk = rint(ang * 0.15915494309189535); const double r = (ang - kk * 6.283185307179586) - kk * 2.4492935982947064e-16;
        const double r2 = r * r; double c = 1.0, s = 1.0, tc = 1.0, ts = 1.0;
#pragma unroll
        for (int n = 1; n <= 14; ++n) { tc *= -r2 / (double)((2 * n - 1) * (2 * n)); ts *= -r2 / (double)((2 * n) * (2 * n + 1)); c += tc; s += ts; }
        cs[2 * i] = (float)c; cs[2 * i + 1] = (float)(s * r); }
}

__device__ __forceinline__ void final_norm_phase(const bf16* xb, const float* rsp, const float* g, float* out, int vcu, int NGW) {
    const int tid = opaque_tid(), lane = tid & 63, gw = vcu * NWAVES + __builtin_amdgcn_readfirstlane(tid >> 6);
    f32x4 gv[8];
#pragma unroll
    for (int j = 0; j < 8; ++j) gv[j] = *((const f32x4*)g + lane + 64 * j);
    for (int m = gw; m < MTOK; m += NGW) {
        const float rstd = pg8::row_rstd(rsp, m);
        const u32x2* xr = (const u32x2*)(xb + (size_t)m * DM) + lane; f32x4* o = (f32x4*)(out + (size_t)m * DM) + lane;
#pragma unroll
        for (int j = 0; j < 8; ++j) { const u32x2 w = xr[64 * j]; o[64 * j] = (f32x4){bf_lo(w.x), bf_hi(w.x), bf_lo(w.y), bf_hi(w.y)} * rstd * gv[j]; }
    }
}

__device__ __forceinline__ void sgu_job(KA a, int l, int job, LAS unsigned char* lds) {
    const int tid = opaque_tid(), lane = tid & 63, wave = __builtin_amdgcn_readfirstlane(tid >> 6);
    const bf16* P = (const bf16*)(a->ws + WS_P); bf16* O = (bf16*)(a->ws + WS_O);
    const int b = job >> 4, n = job & 15; const size_t t0 = (size_t)b * SEQ + n * 128;
    LAS float* rstd = (LAS float*)lds; constexpr int VP = 288, VSZ = 128 * VP;
    { u32x4 wv[16];
#pragma unroll
      for (int i = 0; i < 16; ++i) wv[i] = *(const u32x4*)(P + (t0 + wave * 16 + i) * INW + 512 + lane * 8);
#pragma unroll
      for (int i = 0; i < 16; ++i) { const u32x4 w = wv[i];
          float s = (bf_lo(w.x) * bf_lo(w.x) + bf_hi(w.x) * bf_hi(w.x)) + (bf_lo(w.y) * bf_lo(w.y) + bf_hi(w.y) * bf_hi(w.y)) + (bf_lo(w.z) * bf_lo(w.z) + bf_hi(w.z) * bf_hi(w.z)) + (bf_lo(w.w) * bf_lo(w.w) + bf_hi(w.w) * bf_hi(w.w));
          s = wave_sum(s, lane); if (lane == 0) rstd[wave * 16 + i] = __builtin_amdgcn_rsqf(s * (1.f / BW) + EPS); } }
    const bf16* Wg = (const bf16*)(a->ws + WS_SGUW) + (size_t)l * 4 * 128 * 128;
    const float* gs = a->g_sgu + l * BW; const float* bs = a->b_sgu + l * 128 * 4;
    const int li = lane & 15, G = lane >> 4, c16 = tid & 15;
    u32x4 vr[4];
#pragma unroll
    for (int i = 0; i < 4; ++i) vr[i] = *(const u32x4*)(P + (t0 + (tid >> 4) + 32 * i) * INW + 512 + c16 * 8);
    LDS_BARRIER();
    for (int g = 0; g < 4; ++g) {
        LAS unsigned char* Vl = lds + 1024 + (g & 1) * VSZ;
        { const f32x4 g0 = *(const f32x4*)(gs + g * 128 + c16 * 8), g1 = *(const f32x4*)(gs + g * 128 + c16 * 8 + 4);
#pragma unroll
          for (int i = 0; i < 4; ++i) { const int r = (tid >> 4) + 32 * i; const u32x4 w = vr[i]; const float rs = rstd[r];
              u32x4 o; o.x = cvtpk(bf_lo(w.x) * rs * g0[0], bf_hi(w.x) * rs * g0[1]); o.y = cvtpk(bf_lo(w.y) * rs * g0[2], bf_hi(w.y) * rs * g0[3]);
              o.z = cvtpk(bf_lo(w.z) * rs * g1[0], bf_hi(w.z) * rs * g1[1]); o.w = cvtpk(bf_lo(w.w) * rs * g1[2], bf_hi(w.w) * rs * g1[3]);
              *(LAS u32x4*)(Vl + r * VP + c16 * 16) = o; } }
        if (g + 1 < 4) {
#pragma unroll
            for (int i = 0; i < 4; ++i) vr[i] = *(const u32x4*)(P + (t0 + (tid >> 4) + 32 * i) * INW + 512 + (g + 1) * 128 + c16 * 8); }
        const int t = wave * 16 + li; u32x2 uw[8];
#pragma unroll
        for (int ct = 0; ct < 8; ++ct) uw[ct] = *(const u32x2*)(P + (t0 + t) * INW + g * 128 + ct * 16 + 4 * G);
        const float bb = bs[t * 4 + g];
        LDS_BARRIER();
        f32x4 acc[8];
#pragma unroll
        for (int ct = 0; ct < 8; ++ct) acc[ct] = (f32x4){0.f, 0.f, 0.f, 0.f};
        const int nks = (wave >> 1) + 1;
        for (int ks = 0; ks < nks; ++ks) {
            const bf16x8 wf = *(const bf16x8*)(Wg + ((size_t)g * 128 + wave * 16 + li) * 128 + ks * 32 + G * 8);
#pragma unroll
            for (int ct = 0; ct < 8; ++ct) {
                const LAS unsigned char* p0 = Vl + (ks * 32 + G * 8 + (li >> 2)) * VP + (ct * 16 + 4 * (li & 3)) * 2;
                const s16x4 lo = __builtin_bit_cast(s16x4, __builtin_amdgcn_ds_read_tr16_b64_v4i16((LAS v4i16_t*)p0));
                const s16x4 hi = __builtin_bit_cast(s16x4, __builtin_amdgcn_ds_read_tr16_b64_v4i16((LAS v4i16_t*)(p0 + 4 * VP)));
                const bf16x8 vf = (bf16x8){lo[0], lo[1], lo[2], lo[3], hi[0], hi[1], hi[2], hi[3]};
                acc[ct] = __builtin_amdgcn_mfma_f32_16x16x32_bf16(vf, wf, acc[ct], 0, 0, 0);
            }
        }
#pragma unroll
        for (int ct = 0; ct < 8; ++ct) { const int c = g * 128 + ct * 16 + 4 * G;
            u32x2 o; o.x = cvtpk(bf_lo(uw[ct].x) * (acc[ct][0] + bb), bf_hi(uw[ct].x) * (acc[ct][1] + bb)); o.y = cvtpk(bf_lo(uw[ct].y) * (acc[ct][2] + bb), bf_hi(uw[ct].y) * (acc[ct][3] + bb));
            *(u32x2*)(O + (t0 + t) * DM + c) = o; }
    }
    LDS_BARRIER();
}
__device__ __forceinline__ void sconv_job(KA a, int l, int job) {
    const int tid = opaque_tid();
    const bf16* P = (const bf16*)(a->ws + WS_P); bf16* O = (bf16*)(a->ws + WS_O);
    const int b = job >> 4, n = job & 15, c8 = tid & 63, sg = tid >> 6;
    const float* wc = a->w_sconv + (size_t)l * 3 * BW + c8 * 8;
    float w0[8], w1[8], w2[8];
#pragma unroll
    for (int e = 0; e < 8; ++e) { w0[e] = wc[e]; w1[e] = wc[BW + e]; w2[e] = wc[2 * BW + e]; }
    const bf16* Pb = P + (size_t)b * SEQ * INW + c8 * 8; bf16* Ob = O + (size_t)b * SEQ * DM + 512 + c8 * 8;
    for (int ps = 0; ps < 4; ++ps) {
        const int ts0 = n * 128 + ps * 32 + sg * 4;
        u32x4 cg[6], xc[6], bg[4];
#pragma unroll
        for (int i = 0; i < 6; ++i) { const int tt = ts0 + i - 2; cg[i] = (u32x4){0u, 0u, 0u, 0u}; xc[i] = cg[i];
            if (tt >= 0) { cg[i] = *(const u32x4*)(Pb + (size_t)tt * INW + 1536); xc[i] = *(const u32x4*)(Pb + (size_t)tt * INW + 2048); } }
#pragma unroll
        for (int i = 0; i < 4; ++i) bg[i] = *(const u32x4*)(Pb + (size_t)(ts0 + i) * INW + 1024);
        float pr[6][8];
#pragma unroll
        for (int i = 0; i < 6; ++i) { pr[i][0] = bf_lo(cg[i].x) * bf_lo(xc[i].x); pr[i][1] = bf_hi(cg[i].x) * bf_hi(xc[i].x); pr[i][2] = bf_lo(cg[i].y) * bf_lo(xc[i].y); pr[i][3] = bf_hi(cg[i].y) * bf_hi(xc[i].y);
            pr[i][4] = bf_lo(cg[i].z) * bf_lo(xc[i].z); pr[i][5] = bf_hi(cg[i].z) * bf_hi(xc[i].z); pr[i][6] = bf_lo(cg[i].w) * bf_lo(xc[i].w); pr[i][7] = bf_hi(cg[i].w) * bf_hi(xc[i].w); }
#pragma unroll
        for (int i = 0; i < 4; ++i) { float y[8];
#pragma unroll
            for (int e = 0; e < 8; ++e) y[e] = w0[e] * pr[i][e] + w1[e] * pr[i + 1][e] + w2[e] * pr[i + 2][e];
            u32x4 o; o.x = cvtpk(bf_lo(bg[i].x) * y[0], bf_hi(bg[i].x) * y[1]); o.y = cvtpk(bf_lo(bg[i].y) * y[2], bf_hi(bg[i].y) * y[3]);
            o.z = cvtpk(bf_lo(bg[i].z) * y[4], bf_hi(bg[i].z) * y[5]); o.w = cvtpk(bf_lo(bg[i].w) * y[6], bf_hi(bg[i].w) * y[7]);
            *(u32x4*)(Ob + (size_t)(ts0 + i) * DM) = o; }
    }
}
__device__ __forceinline__ void moba_job(KA a, int job, unsigned char* lds_g) {
    const int tid = opaque_tid();
    const bf16* P = (const bf16*)(a->ws + WS_P); bf16* O = (bf16*)(a->ws + WS_O);
    const int bh = job >> 2, x = job & 3, b = bh >> 2, h = bh & 3, oS = x, oB = 7 - x;
    const bf16* Qb = P + (size_t)b * SEQ * INW + 2560 + h * 128; const bf16* Kb = P + (size_t)b * SEQ * INW + 3072 + h * 128; const bf16* Vb = P + (size_t)b * SEQ * INW + 3584 + h * 128;
    bf16* Ob = O + (size_t)b * SEQ * DM + 1024 + h * 128;
    unsigned* selm = (unsigned*)(lds_g + att::OFF_SEL); float* kmean = (float*)(lds_g + att::OFF_KMEAN); float* part = (float*)(lds_g + att::OFF_PART);
    { const int g = tid >> 4, c = tid & 15;
      for (int j = 0; j < oB; ++j) {
          float s[8];
#pragma unroll
          for (int e = 0; e < 8; ++e) s[e] = 0.f;
#pragma unroll
          for (int i = 0; i < 8; ++i) { const u32x4 w = *(const u32x4*)(Kb + (size_t)(j * 256 + g * 8 + i) * INW + c * 8);
              s[0] += bf_lo(w.x); s[1] += bf_hi(w.x); s[2] += bf_lo(w.y); s[3] += bf_hi(w.y); s[4] += bf_lo(w.z); s[5] += bf_hi(w.z); s[6] += bf_lo(w.w); s[7] += bf_hi(w.w); }
          *(f32x4*)(part + g * 128 + c * 8) = (f32x4){s[0], s[1], s[2], s[3]}; *(f32x4*)(part + g * 128 + c * 8 + 4) = (f32x4){s[4], s[5], s[6], s[7]};
          LDS_BARRIER();
          if (tid < 128) { float t = 0.f;
#pragma unroll 8
              for (int gg = 0; gg < 32; ++gg) t += part[gg * 128 + tid];
              kmean[j * 128 + tid] = t * (1.f / 256.f); }
          LDS_BARRIER();
      } }
    if (tid < 256) selm[tid] = (1u << oS) - 1u;
    { const int qr = tid >> 1, hf = tid & 1; const bf16* qp = Qb + (size_t)(oB * 256 + qr) * INW + hf * 64;
      float q[64];
#pragma unroll
      for (int i = 0; i < 8; ++i) { const u32x4 w = *(const u32x4*)(qp + i * 8);
          q[i * 8 + 0] = bf_lo(w.x); q[i * 8 + 1] = bf_hi(w.x); q[i * 8 + 2] = bf_lo(w.y); q[i * 8 + 3] = bf_hi(w.y); q[i * 8 + 4] = bf_lo(w.z); q[i * 8 + 5] = bf_hi(w.z); q[i * 8 + 6] = bf_lo(w.w); q[i * 8 + 7] = bf_hi(w.w); }
      float v1 = -3e38f, v2 = -3e38f, v3 = -3e38f; int i1 = 0, i2 = 0, i3 = 0;
      for (int j = 0; j < oB; ++j) { const float* km = kmean + j * 128 + hf * 64; float s = 0.f;
#pragma unroll
          for (int d = 0; d < 64; d += 4) { const f32x4 kv = *(const f32x4*)(km + d); s += q[d] * kv[0] + q[d + 1] * kv[1] + q[d + 2] * kv[2] + q[d + 3] * kv[3]; }
          s += shfl_x(s, 1, tid & 63);
          if (s > v1) { v3 = v2; i3 = i2; v2 = v1; i2 = i1; v1 = s; i1 = j; }
          else if (s > v2) { v3 = v2; i3 = i2; v2 = s; i2 = j; }
          else if (s > v3) { v3 = s; i3 = j; } }
      if (hf == 0) selm[256 + qr] = (1u << i1) | (1u << i2) | (1u << i3); }
    LDS_BARRIER();
    const att::Heads HD{Qb, Kb, Vb, Ob};
    const att::BlockRef r0{oS * 256, 0}, r1{oB * 256, 1};
    att::Seam S;
    att::moba_prime(HD, r0, (char*)lds_g, S);
    att::moba_block(HD, r0, r1, (char*)lds_g, S);
    att::moba_block(HD, r1, r1, (char*)lds_g, S);
}
__device__ __forceinline__ void lru_job(KA a, int l, int job, LAS unsigned char* lds) {
    const int tid = opaque_tid(), lane = tid & 63, wave = __builtin_amdgcn_readfirstlane(tid >> 6);
    const bf16* P = (const bf16*)(a->ws + WS_P); bf16* O = (bf16*)(a->ws + WS_O);
    const int b = job >> 4, g = (job >> 2) & 3, q4 = job & 3;
    constexpr int XP = 272, AP = 144;
    LAS unsigned char* XR = lds;
    LAS float* ABbase = (LAS float*)(lds + 34816);
    const int li = lane & 15, G = lane >> 4;
    bf16x8 wf[4][4];
    { const bf16* lw = (const bf16*)(a->ws + WS_LRUW) + ((size_t)((l * 4 + g) * 4 + q4)) * 64 * 128;
#pragma unroll
      for (int nt = 0; nt < 4; ++nt)
#pragma unroll
          for (int ks = 0; ks < 4; ++ks) wf[nt][ks] = *(const bf16x8*)(lw + (nt * 16 + li) * 128 + ks * 32 + G * 8); }
    float ba[2], bx[2], sp[2];
#pragma unroll
    for (int n2 = 0; n2 < 2; ++n2) { const int ch = l * BW + g * 128 + q4 * 32 + n2 * 16 + li; ba[n2] = a->b_lru_a[ch]; bx[n2] = a->b_lru_x[ch]; sp[n2] = ((const float*)(a->ws + WS_SPLUS))[ch]; }
    const int c16 = tid & 15, rg = tid >> 4;
    float cw[4][8], cb[8];
    { const float* wp = a->w_lru_conv + (size_t)l * 4 * BW + g * 128 + c16 * 8; const float* bp = a->b_lru_conv + (size_t)l * BW + g * 128 + c16 * 8;
#pragma unroll
      for (int e = 0; e < 8; ++e) { cw[0][e] = wp[e]; cw[1][e] = wp[BW + e]; cw[2][e] = wp[2 * BW + e]; cw[3][e] = wp[3 * BW + e]; cb[e] = bp[e]; } }
    const bf16* Pb = P + (size_t)b * SEQ * INW;
    const int sg = lane & 15, jc = wave * 4 + (lane >> 4);
    const bf16* Gp = Pb + 4608 + g * 128 + q4 * 32 + jc;
    bf16* Op = O + (size_t)b * SEQ * DM + 1536 + g * 128 + q4 * 32 + jc;
    float carry = 0.f;
    u32x4 raw[7];
#pragma unroll
    for (int i = 0; i < 7; ++i) { const int tt = rg * 4 + i - 3; raw[i] = (u32x4){0u, 0u, 0u, 0u}; if (tt >= 0) raw[i] = *(const u32x4*)(Pb + (size_t)tt * INW + 4096 + g * 128 + c16 * 8); }
    for (int tb = 0; tb < SEQ / 128; ++tb) {
        const int t0 = tb * 128;
        LAS float* Al = ABbase + (tb & 1) * 2 * 32 * AP; LAS float* Bl = Al + 32 * AP;
#pragma unroll
        for (int i = 0; i < 4; ++i) { float y[8];
#pragma unroll
            for (int e = 0; e < 8; ++e) y[e] = cb[e];
#pragma unroll
            for (int kq = 0; kq < 4; ++kq) { const u32x4 w = raw[i + kq];
                y[0] += cw[kq][0] * bf_lo(w.x); y[1] += cw[kq][1] * bf_hi(w.x); y[2] += cw[kq][2] * bf_lo(w.y); y[3] += cw[kq][3] * bf_hi(w.y);
                y[4] += cw[kq][4] * bf_lo(w.z); y[5] += cw[kq][5] * bf_hi(w.z); y[6] += cw[kq][6] * bf_lo(w.w); y[7] += cw[kq][7] * bf_hi(w.w); }
            u32x4 o; o.x = cvtpk(y[0], y[1]); o.y = cvtpk(y[2], y[3]); o.z = cvtpk(y[4], y[5]); o.w = cvtpk(y[6], y[7]);
            *(LAS u32x4*)(XR + (rg * 4 + i) * XP + c16 * 16) = o; }
        if (tb + 1 < SEQ / 128) {
#pragma unroll
            for (int i = 0; i < 7; ++i) raw[i] = *(const u32x4*)(Pb + (size_t)(t0 + 128 + rg * 4 + i - 3) * INW + 4096 + g * 128 + c16 * 8); }
        bf16 gt[8];
#pragma unroll
        for (int i = 0; i < 8; ++i) gt[i] = Gp[(size_t)(t0 + sg * 8 + i) * INW];
        LDS_BARRIER();
        { f32x4 acc[4];
#pragma unroll
          for (int nt = 0; nt < 4; ++nt) acc[nt] = (f32x4){0.f, 0.f, 0.f, 0.f};
#pragma unroll
          for (int ks = 0; ks < 4; ++ks) { const bf16x8 xf = *(const LAS bf16x8*)(XR + (wave * 16 + li) * XP + (ks * 32 + G * 8) * 2);
#pragma unroll
              for (int nt = 0; nt < 4; ++nt) acc[nt] = __builtin_amdgcn_mfma_f32_16x16x32_bf16(xf, wf[nt][ks], acc[nt], 0, 0, 0); }
#pragma unroll
          for (int n2 = 0; n2 < 2; ++n2)
#pragma unroll
              for (int r = 0; r < 4; ++r) { const int t = wave * 16 + G * 4 + r, j = n2 * 16 + li;
                  const float rr = sigmoidf_(acc[n2][r] + ba[n2]), ii = sigmoidf_(acc[2 + n2][r] + bx[n2]);
                  const float la = -8.0f * rr * sp[n2]; const float av = __expf(la); const float x2 = 2.0f * la;
                  const float em = (x2 > -0.25f) ? -x2 * (1.0f + x2 * (0.5f + x2 * (0.16666667f + x2 * (0.041666668f + x2 * (0.0083333338f + x2 * 0.0013888889f))))) : (1.0f - av * av);
                  const float mult = __builtin_amdgcn_sqrtf(em);
                  const float xv = bf2f(*(const LAS bf16*)(XR + t * XP + (q4 * 32 + j) * 2));
                  const int pos = (t & 7) * 16 + (t >> 3);
                  Al[j * AP + pos] = av; Bl[j * AP + pos] = mult * (ii * xv); } }
        LDS_BARRIER();
        { float av[8], bv[8]; float Ac = 1.f, Hc = 0.f;
#pragma unroll
          for (int i = 0; i < 8; ++i) { av[i] = Al[jc * AP + i * 16 + sg]; bv[i] = Bl[jc * AP + i * 16 + sg]; Hc = av[i] * Hc + bv[i]; Ac *= av[i]; }
#pragma unroll
          for (int d = 1; d < 16; d <<= 1) { const float Ap_ = shfl_up16(Ac, d, lane), Hp_ = shfl_up16(Hc, d, lane); if (sg >= d) { Hc = Ac * Hp_ + Hc; Ac = Ac * Ap_; } }
          const float hend = Ac * carry + Hc;
          float h = shfl_up16(hend, 1, lane); if (sg == 0) h = carry;
          carry = shfl_idx(hend, lane | 15);
#pragma unroll
          for (int i = 0; i < 8; ++i) { h = av[i] * h + bv[i]; Op[(size_t)(t0 + sg * 8 + i) * DM] = (bf16)f2bf(gelu_tanh(bf2f(gt[i])) * h); } }
    }
    __syncthreads();
}

__global__ void __launch_bounds__(NTHR, 2) mk_fwd(Args args) {
    extern __shared__ __attribute__((aligned(16))) unsigned char lds_g[];
    LAS unsigned char* lds = (LAS unsigned char*)lds_g;
    volatile LAS unsigned* MISC = (volatile LAS unsigned*)(lds + MISC_OFF);
    const KA ka = (KA)__builtin_amdgcn_kernarg_segment_ptr();
    const int G = gridDim.x, bx = blockIdx.x;
    const int vcu = (G % 8 == 0) ? (bx % 8) * (G / 8) + bx / 8 : bx;
    const int NGW = G * NWAVES;
    if (threadIdx.x < 32) MISC[threadIdx.x] = 0u;
    __syncthreads();
    XcdBarrier bar = xcd_barrier_post((unsigned*)(ka->ws + WS_CTL) + CW_BAR + ka->li * XCD_BAR_WORDS, MISC + 8);
    const int lo = ka->ph_lo, hi = ka->ph_hi;
#ifndef PHSEL
#define PHSEL(k) true
#endif
#if MK_N_LAUNCHES == 1
#define IN(k) (PHSEL(k))
#else
#define IN(k) (PHSEL(k) && lo <= (k) && (k) < hi)
#endif
#define SEAM(k) do { if (IN((k) + 1)) xcd_barrier(bar); } while (0)
#ifndef DUPMASK
#define DUPMASK 0
#endif
#define REPS(j) (((DUPMASK >> (j)) & 1) ? 2 : 1)

    if (IN(0)) for (int rep = 0; rep < REPS(0); ++rep) {
        prologue_phase(opaque_ka(ka), lds, vcu, NGW, 0, 0); wmax_phase(opaque_ka(ka), vcu, NGW, 0); xcd_barrier(bar);
        for (int l = 0; l < DEPTH; ++l) { prologue_phase(opaque_ka(ka), lds, vcu, NGW, 1, l);
            if (l + 1 < DEPTH) { wmax_phase(opaque_ka(ka), vcu, NGW, l + 1); xcd_barrier(bar); } }
        prologue_phase(opaque_ka(ka), lds, vcu, NGW, 2, 0); SEAM(0); }

    for (int l = 0; l < DEPTH; ++l) {
        const int pb = 1 + 6 * l;
        if (IN(pb + 0)) for (int rep = 0; rep < REPS(1); ++rep) {
            const KA a = opaque_ka(ka); unsigned char* ws = a->ws; const unsigned char* wl = ws + WS_W + (size_t)l * W_LAYER;
            typedef pg8::GemmSched<MTOK / 256, INW / 256> Sch; Sch S; S.T.init(G, bx); S.A = (const char*)(ws + WS_XB); S.B = (const char*)(wl + WO_IN); S.tA = (size_t)256 * DM * 2; S.tB = (size_t)256 * DM * 2; S.nt = DM / 64;
            pg8::EpiP E{(bf16*)(ws + WS_P), (const float*)(ws + WS_ROPE), (const float*)(ws + WS_RSA)};
            pg8::gemm_phase<pg8::EpiP, Sch>(lds, DM, DM, S, E);
            SEAM(pb + 0);
        }
        if (IN(pb + 1)) for (int rep = 0; rep < REPS(2); ++rep) {
#ifndef DUP3SEL
#define DUP3SEL 15
#endif
            if (rep == 0 || (DUP3SEL & 1)) for (int job = vcu; job < 256; job += G) moba_job(opaque_ka(ka), job, lds_g);
            if (rep == 0 || (DUP3SEL & 2)) for (int job = vcu; job < 256; job += G) lru_job(opaque_ka(ka), l, job, lds);
            if (rep == 0 || (DUP3SEL & 4)) for (int job = vcu; job < 256; job += G) sgu_job(opaque_ka(ka), l, job, lds);
            if (rep == 0 || (DUP3SEL & 8)) for (int job = vcu; job < 256; job += G) sconv_job(opaque_ka(ka), l, job);
            SEAM(pb + 1);
        }
        if (IN(pb + 2)) for (int rep = 0; rep < REPS(3); ++rep) {
            const KA a = opaque_ka(ka); unsigned char* ws = a->ws; const unsigned char* wl = ws + WS_W + (size_t)l * W_LAYER;
            pg8::GateSched S; S.T.init(G, bx); S.XQ = (const char*)a->out; S.O = (const char*)(ws + WS_O); S.Wgb = (const char*)(wl + WO_GB);
            pg8::EpiGate E{(bf16*)(ws + WS_Y), a->b_gate + (size_t)l * 4 * DM, (char*)(ws + WS_SCR + (size_t)bx * SCR_PER_CU), (const float*)(ws + WS_RSA), (LAS u32x4*)(lds + SST_OFF), (LAS u32x4*)(lds + YST_OFF), (const float*)(ws + WS_XQS), (const unsigned*)(ws + WS_CTL) + CW_WMAX + l * 4, {}};
            pg8::gemm_phase<pg8::EpiGate, pg8::GateSched>(lds, DM, GBP / 2, S, E);
            SEAM(pb + 2);
        }
        if (IN(pb + 3)) {
            const KA a = opaque_ka(ka); unsigned char* ws = a->ws; const unsigned char* wl = ws + WS_W + (size_t)l * W_LAYER;
            typedef pg8::GemmSched<MTOK / 256, DM / 256> Sch; Sch S; S.T.init(G, bx); S.A = (const char*)(ws + WS_Y); S.B = (const char*)(wl + WO_OUT); S.tA = (size_t)256 * DM * 2; S.tB = (size_t)256 * DM * 2; S.nt = DM / 64;
            pg8::EpiResBf E{(bf16*)(ws + WS_XB), (float*)(ws + WS_RSB), (LAS float*)(lds + RED_OFF), (unsigned char*)a->out + 2048, (const float*)(ws + WS_MXA), (float*)(ws + WS_XQS) + MTOK, (float*)(ws + WS_MXB), (LAS float*)(lds + SST_OFF)};
            pg8::gemm_phase<pg8::EpiResBf, Sch>(lds, DM, DM, S, E);
            SEAM(pb + 3);
        }
        if (IN(pb + 4)) for (int rep = 0; rep < REPS(5); ++rep) {
            const KA a = opaque_ka(ka); unsigned char* ws = a->ws; const unsigned char* wl = ws + WS_W + (size_t)l * W_LAYER;
            typedef pg8::GemmSched<MTOK / 256, (2 * DFF) / 256> Sch; Sch S; S.T.init(G, bx); S.A = (const char*)a->out + 2048; S.B = (const char*)(wl + WO_13); S.tA = (size_t)256 * XQP; S.tB = (size_t)256 * DM; S.nt = DM / 128;
            pg8::EpiSwiglu E{(bf16*)(ws + WS_H), (const float*)(ws + WS_RSB), (const float*)(ws + WS_XQS) + MTOK, (const unsigned*)(ws + WS_CTL) + CW_CMAX + (size_t)2 * l * DFF};
            pg8::gemm_phase<pg8::EpiSwiglu, Sch>(lds, XQP / 2, DM / 2, S, E);
            SEAM(pb + 4);
        }
        if (IN(pb + 5)) {
            const KA a = opaque_ka(ka); unsigned char* ws = a->ws; const unsigned char* wl = ws + WS_W + (size_t)l * W_LAYER;
            typedef pg8::GemmSched<MTOK / 256, DM / 256> Sch; Sch S; S.T.init(G, bx); S.A = (const char*)(ws + WS_H); S.B = (const char*)(wl + WO_2); S.tA = (size_t)256 * DFF * 2; S.tB = (size_t)256 * DFF * 2; S.nt = DFF / 64;
            pg8::EpiResBf E{(bf16*)(ws + WS_XB), (float*)(ws + WS_RSA), (LAS float*)(lds + RED_OFF), (l + 1 < DEPTH) ? (unsigned char*)a->out : nullptr, (const float*)(ws + WS_MXB), (float*)(ws + WS_XQS), (float*)(ws + WS_MXA), (LAS float*)(lds + SST_OFF)};
            pg8::gemm_phase<pg8::EpiResBf, Sch>(lds, DFF, DFF, S, E);
            SEAM(pb + 5);
        }
    }
    if (IN(NPHASE - 1)) { const KA a = opaque_ka(ka); unsigned char* ws = a->ws; final_norm_phase((const bf16*)(ws + WS_XB), (const float*)(ws + WS_RSA), a->g_final, a->out, vcu, NGW); }
#undef IN
#undef SEAM
}

extern "C" void kernel_launch(void* const* d_in, const int* in_sizes, int n_in, void* d_out, int out_size, void* d_ws, size_t ws_size, hipStream_t stream) {
    static int grid = 0;
    if (grid == 0) {
        if (n_in != 23 || in_sizes[0] != MTOK * DM || out_size != MTOK * DM || ws_size < WS_END) {
            fprintf(stderr, "kernel_launch: built for 23 inputs, x/out of %d floats, >= %zu bytes of workspace; got n_in %d, in0 %d, out %d, ws %zu; nothing launched\n", MTOK * DM, (size_t)WS_END, n_in, n_in > 0 ? in_sizes[0] : -1, out_size, ws_size);
            grid = -1; return; }
        int dev = 0, cus = 0, per_cu = 0;
        if (hipGetDevice(&dev) != hipSuccess || hipDeviceGetAttribute(&cus, hipDeviceAttributeMultiprocessorCount, dev) != hipSuccess) { fprintf(stderr, "kernel_launch: device query failed\n"); grid = -1; return; }
        if (hipFuncSetAttribute((const void*)mk_fwd, hipFuncAttributeMaxDynamicSharedMemorySize, LDS_BYTES) != hipSuccess) { fprintf(stderr, "kernel_launch: hipFuncSetAttribute failed\n"); grid = -1; return; }
        if (hipOccupancyMaxActiveBlocksPerMultiprocessor(&per_cu, (const void*)mk_fwd, NTHR, LDS_BYTES) != hipSuccess || per_cu < 1)
            fprintf(stderr, "kernel_launch: note: occupancy query reports %d workgroups per CU\n", per_cu);
        (void)hipGetLastError();
        grid = cus;
    }
    if (grid < 0) return;
    if (hipMemsetAsync((char*)d_ws + WS_CTL, 0, CTL_ZERO_BYTES, stream) != hipSuccess) { fprintf(stderr, "kernel_launch: memset failed\n"); return; }
    Args a{};
    a.x = (const float*)d_in[0]; a.g_mix = (const float*)d_in[1]; a.w_in = (const float*)d_in[2]; a.w_sgu = (const float*)d_in[3]; a.b_sgu = (const float*)d_in[4]; a.g_sgu = (const float*)d_in[5];
    a.w_sconv = (const float*)d_in[6]; a.w_lru_conv = (const float*)d_in[7]; a.b_lru_conv = (const float*)d_in[8]; a.w_lru_a = (const float*)d_in[9]; a.b_lru_a = (const float*)d_in[10];
    a.w_lru_x = (const float*)d_in[11]; a.b_lru_x = (const float*)d_in[12]; a.lru_lambda = (const float*)d_in[13]; a.w_gate = (const float*)d_in[14]; a.b_gate = (const float*)d_in[15];
    a.w_branch = (const float*)d_in[16]; a.w_out = (const float*)d_in[17]; a.g_ffn = (const float*)d_in[18]; a.w_ffn1 = (const float*)d_in[19]; a.w_ffn3 = (const float*)d_in[20];
    a.w_ffn2 = (const float*)d_in[21]; a.g_final = (const float*)d_in[22];
    a.out = (float*)d_out; a.ws = (unsigned char*)d_ws; a.pad = 0;
#if MK_N_LAUNCHES == 1
    a.ph_lo = 0; a.ph_hi = NPHASE; a.li = 0;
    hipLaunchKernelGGL(mk_fwd, dim3(grid), dim3(NTHR), LDS_BYTES, stream, a);
#else
    for (int ph = 0; ph < NPHASE; ++ph) { a.ph_lo = ph; a.ph_hi = ph + 1; a.li = ph;
        hipLaunchKernelGGL(mk_fwd, dim3(grid), dim3(NTHR), LDS_BYTES, stream, a); }
#endif
    const hipError_t le = hipPeekAtLastError();
    if (le != hipSuccess) fprintf(stderr, "kernel_launch: launch failed: %s\n", hipGetErrorName(le));
}
```

```cpp
#include <hip/hip_runtime.h>
#include <cstdio>
#include <cstdint>
#include <type_traits>

#define GAS __attribute__((address_space(1)))
#define LAS __attribute__((address_space(3)))
typedef unsigned short bf16;
typedef short bf16x8 __attribute__((ext_vector_type(8)));
typedef short s16x4 __attribute__((ext_vector_type(4)));
typedef short v4i16_t __attribute__((ext_vector_type(4)));
typedef float f32x2 __attribute__((ext_vector_type(2)));
typedef float f32x4 __attribute__((ext_vector_type(4)));
typedef float f32x16 __attribute__((ext_vector_type(16)));
typedef unsigned u32x2 __attribute__((ext_vector_type(2)));
typedef unsigned u32x4 __attribute__((ext_vector_type(4)));

#ifndef MK_N_LAUNCHES
#define MK_N_LAUNCHES 1
#endif

constexpr int DM = 2048, NB = 16, SEQ = 2048, DEPTH = 4, MTOK = NB * SEQ, BW = 512, INW = 5120, DFF = 5632;
constexpr int NWAVES = 8, NTHR = 512;
constexpr float EPS = 1e-6f;
constexpr int NPHASE = 2 + 6 * DEPTH;

constexpr size_t MiB = 1u << 20;
constexpr size_t WS_CTL = 0, CTL_ZERO_BYTES = 1 * MiB;
constexpr size_t WS_W = 1 * MiB, W_LAYER = 134 * MiB;
constexpr size_t WO_IN = 0, WO_GB = 20 * MiB, WO_OUT = 60 * MiB, WO_13 = 68 * MiB, WO_2 = 112 * MiB;
constexpr size_t WS_SGUW = 537 * MiB, WS_LRUW = 538 * MiB, WS_ROPE = 539 * MiB;
constexpr size_t WS_SPLUS = WS_SGUW + 512 * 1024;
constexpr size_t WS_XB = 540 * MiB, WS_P = 668 * MiB, WS_O = 988 * MiB, WS_Y = 1116 * MiB, WS_RSA = 1244 * MiB, WS_RSB = 1245 * MiB, WS_XQS = 1246 * MiB, WS_MXA = 1247 * MiB, WS_MXB = 1248 * MiB, WS_END = 1249 * MiB;
constexpr size_t WS_H = WS_P;
constexpr size_t WS_SCR = WS_P;
constexpr size_t SCR_PER_CU = 256 * 1024;
static_assert((size_t)INW * DM * 2 <= WO_GB && WO_GB + (size_t)4 * DM * 3072 <= WO_OUT && WO_OUT + (size_t)DM * DM * 2 <= WO_13 &&
              WO_13 + (size_t)2 * DFF * DM * 2 <= WO_2 && WO_2 + (size_t)DM * DFF * 2 <= W_LAYER, "weight map");
static_assert(WS_W + DEPTH * W_LAYER <= WS_SGUW && WS_P + (size_t)MTOK * INW * 2 <= WS_O && WS_H + (size_t)MTOK * DFF * 2 <= WS_Y, "ws map");
constexpr int CW_WMAX = 131072;
constexpr int CW_CMAX = 65536;
constexpr int CW_BAR = 4096;

constexpr int RING_BYTES = 131072;
constexpr int LDS_BYTES = 163840;
constexpr int MISC_OFF = LDS_BYTES - 128;
constexpr int RED_OFF = MISC_OFF - 4096;
constexpr int SST_OFF = RED_OFF - 8192;
constexpr int YST_OFF = SST_OFF - 16384;
constexpr int PRO_SCR = 64 * 65 * 4;
static_assert(8 * PRO_SCR <= YST_OFF && YST_OFF >= RING_BYTES, "LDS map");

#define LDS_WAIT() asm volatile("s_waitcnt lgkmcnt(0)" ::: "memory")
#define VM_WAIT() asm volatile("s_waitcnt vmcnt(0)" ::: "memory")
#define SBAR() __builtin_amdgcn_sched_barrier(0)
#define LDS_BARRIER() do { asm volatile("s_waitcnt lgkmcnt(0)" ::: "memory"); __builtin_amdgcn_s_barrier(); asm volatile("" ::: "memory"); } while (0)

typedef __bf16 bf16x2_t __attribute__((ext_vector_type(2)));
__device__ __forceinline__ unsigned cvtpk(float lo, float hi) { const f32x2 v = {lo, hi}; const bf16x2_t b = __builtin_convertvector(v, bf16x2_t); return __builtin_bit_cast(unsigned, b); }
__device__ __forceinline__ float bf_lo(unsigned w) { return __uint_as_float(w << 16); }
__device__ __forceinline__ float bf_hi(unsigned w) { return __uint_as_float(w & 0xffff0000u); }
__device__ __forceinline__ float bf2f(bf16 b) { return __uint_as_float(((unsigned)b) << 16); }
__device__ __forceinline__ unsigned f2bf(float f) { unsigned u = __float_as_uint(f); return (u + 0x7fffu + ((u >> 16) & 1u)) >> 16; }
__device__ __forceinline__ float sigmoidf_(float x) { return __builtin_amdgcn_rcpf(1.0f + __expf(-x)); }
constexpr float LOG2E = 1.4426950408889634f;
__device__ __forceinline__ float sig255(float t) { return __builtin_amdgcn_rcpf(__builtin_amdgcn_exp2f(t) + (1.0f / 255.0f)); }
__device__ __forceinline__ float gelu_tanh(float x) { const float t = x * __builtin_fmaf(x * x, -2.0f * 0.7978845608028654f * 0.044715f * 1.4426950408889634f, -2.0f * 0.7978845608028654f * 1.4426950408889634f); return x * __builtin_amdgcn_rcpf(1.0f + __builtin_amdgcn_exp2f(t)); }
typedef int i32x4 __attribute__((ext_vector_type(4)));
typedef int i32x8 __attribute__((ext_vector_type(8)));
constexpr int XQP = 4096;
constexpr int GBP = 3072;
constexpr float XQ_CLIP = 1.05f;
__device__ __forceinline__ float xq_dx(float amax) { return (XQ_CLIP / 127.0f) * amax + 1e-20f; }
__device__ __forceinline__ float q8r(float v) { return __builtin_amdgcn_fmed3f(v, -127.f, 127.f) + 12582912.0f; }
__device__ __forceinline__ unsigned pack4_i8(float r0, float r1, float r2, float r3) {
    const unsigned p01 = __builtin_amdgcn_perm(__builtin_bit_cast(unsigned, r1), __builtin_bit_cast(unsigned, r0), 0x0c0c0400u);
    const unsigned p23 = __builtin_amdgcn_perm(__builtin_bit_cast(unsigned, r3), __builtin_bit_cast(unsigned, r2), 0x04000c0cu);
    return p01 | p23; }
__device__ __forceinline__ unsigned quant4_i8(float a, float b, float c, float d, float sx) { return pack4_i8(q8r(a * sx), q8r(b * sx), q8r(c * sx), q8r(d * sx)); }
__device__ __forceinline__ int opaque_tid() { int t = threadIdx.x; asm volatile("" : "+v"(t)); return t; }
template <class T> __device__ __forceinline__ T* opaque_ptr(T* p) { return p; }
__device__ __forceinline__ float shfl_idx(float v, int src) { return __builtin_bit_cast(float, __builtin_amdgcn_ds_bpermute(src << 2, __builtin_bit_cast(int, v))); }
__device__ __forceinline__ float shfl_x(float v, int m, int lane) { return shfl_idx(v, lane ^ m); }
__device__ __forceinline__ float shfl_up16(float v, int d, int lane) { return shfl_idx(v, ((lane & 15) >= d) ? lane - d : lane); }
__device__ __forceinline__ float wave_sum(float v, int lane) {
#pragma unroll
    for (int o = 1; o < 64; o <<= 1) v += shfl_x(v, o, lane);
    return v;
}

namespace pg8 {
constexpr int BM = 256, BK = 64, HALF = 128, HTB = HALF * BK * 2, STAGE_BYTES = 8 * HTB, NXCD = 8, WGM = 4;
__host__ __device__ __forceinline__ int lds_byte(int r, int c) { const int st = (r >> 4) * 2 + (c >> 5), rr = r & 15, cc = c & 31, ob = rr * 64 + cc * 2; return st * 1024 + (ob ^ (((ob >> 9) & 1) << 5)); }
__host__ __device__ __forceinline__ void stage_rc(int b, int& R, int& C) { const int st = b / 1024, sb = b % 1024, swz = sb ^ (((sb >> 9) & 1) << 5); R = (st >> 1) * 16 + swz / 64; C = (st & 1) * 32 + (swz % 64) / 2; }
__host__ __device__ __forceinline__ int perm32(int rho) { const int n = rho >> 4, i = rho & 15; return 8 * (i >> 2) + 4 * n + (i & 3); }

struct Unit { const char* A; const char* B; int nt, kind, pm, pn; };

template <int NM, int NN> struct TileOrder {
    static_assert(NM % WGM == 0 && (NM * NN) % NXCD == 0, "tile grid");
    int G, c;
    __device__ void init(int G_, int c_) { G = G_; c = c_; }
    __device__ __forceinline__ bool tile(int i, int& pm, int& pn) const {
        constexpr int nwg = NM * NN, q = nwg / NXCD, nig = WGM * NN;
        const int L = i * G + c; if (L >= nwg) return false;
        const int wgid = (L % NXCD) * q + L / NXCD;
        const int gid = wgid / nig, w = wgid % nig;
        pm = gid * WGM + (w % WGM); pn = w / WGM; return true;
    }
};
template <int NM, int NN> struct GemmSched {
    TileOrder<NM, NN> T; const char* A; const char* B; size_t tA, tB; int nt;
    __device__ __forceinline__ bool next(int i, Unit& u) const { int pm, pn; if (!T.tile(i, pm, pn)) return false;
        u.A = A + (size_t)pm * tA; u.B = B + (size_t)pn * tB; u.nt = nt; u.kind = 0; u.pm = pm; u.pn = pn; return true; }
};
struct GateSched {
    TileOrder<MTOK / 256, DM / 256> T; const char* XQ; const char* O; const char* Wgb;
    __device__ __forceinline__ bool next(int i, Unit& u) const { int pm, pn; if (!T.tile(i >> 3, pm, pn)) return false;
        const int seg = i & 7, k = seg >> 1, br = seg & 1;
        u.A = br ? O + ((size_t)pm * 256 * DM + (size_t)k * BW) * 2 : XQ + (size_t)pm * 256 * XQP;
        u.B = Wgb + (size_t)(k * DM + pn * 256) * GBP + (br ? 2048 : 0);
        u.nt = br ? 8 : 16; u.kind = seg; u.pm = pm; u.pn = pn; return true; }
};

template <class Epi, class Sched>
__device__ __forceinline__ void gemm_phase(LAS unsigned char* lds, const int lda, const int ldb, const Sched& S, const Epi& E) {
    const int tid = opaque_tid(), wid = __builtin_amdgcn_readfirstlane(tid >> 6), lane = tid & 63, wr = wid >> 2, wc = wid & 3, fr = lane & 15, fq = lane >> 4;
    unsigned voffA, voffB;
    { int R, C; stage_rc(tid * 16, R, C); const int Rb = Epi::PERM ? ((R & ~31) + perm32(R & 31)) : R;
        voffA = (unsigned)(R * lda + C) * 2u; voffB = (unsigned)(Rb * ldb + C) * 2u; }
    const size_t kstep = (size_t)(BK * 2);
    const size_t hstepA = (size_t)HALF * lda * 2, hstepB = (size_t)HALF * ldb * 2;
    const unsigned ldsw = (unsigned)wid * 1024u;
    const int aoff = lds_byte(wr * 64 + fr, fq * 8), boff = lds_byte(wc * 32 + fr, fq * 8);
#define PG8_SA(b, h) (((b) * 2 + (h)) * HTB)
#define PG8_SB(b, h) ((4 + (b) * 2 + (h)) * HTB)
#define PG8_STAGE(bufoff, gbase, voff, hstep) do { const char* g_ = (const char*)(gbase); asm volatile("" : "+s"(g_)); \
        __builtin_amdgcn_global_load_lds((const unsigned*)(g_ + (voff)), (LAS unsigned*)(lds + (bufoff) + ldsw), 16, 0, 0); \
        const char* h_ = g_ + ((hstep) >> 1); asm volatile("" : "+s"(h_));                   \
        __builtin_amdgcn_global_load_lds((const unsigned*)(h_ + (voff)), (LAS unsigned*)(lds + (bufoff) + ldsw + 8192), 16, 0, 0); } while (0)
#define PG8_LDA(dst, b, h) do { _Pragma("unroll") for (int m = 0; m < 4; ++m) _Pragma("unroll") for (int k = 0; k < 2; ++k) dst[m][k] = *(const LAS bf16x8*)(lds + PG8_SA(b, h) + aoff + m * 2048 + k * 1024); } while (0)
#define PG8_LDB(dst, b, h) do { _Pragma("unroll") for (int n = 0; n < 2; ++n) _Pragma("unroll") for (int k = 0; k < 2; ++k) dst[n][k] = *(const LAS bf16x8*)(lds + PG8_SB(b, h) + boff + n * 2048 + k * 1024); } while (0)
#define PG8_MMA(ai, bj, At, Bt) do { __builtin_amdgcn_iglp_opt(0); __builtin_amdgcn_s_setprio(1); _Pragma("unroll") for (int m = 0; m < 4; ++m) _Pragma("unroll") for (int n = 0; n < 2; ++n) _Pragma("unroll") for (int k = 0; k < 2; ++k) \
        acc[ai][bj][m][n] = __builtin_amdgcn_mfma_f32_16x16x32_bf16(Bt[n][k], At[m][k], acc[ai][bj][m][n], 0, 0, 0); __builtin_amdgcn_s_setprio(0); } while (0)
#define PG8_MMA8(ai, bj, At, Bt) do { __builtin_amdgcn_iglp_opt(0); __builtin_amdgcn_s_setprio(1); _Pragma("unroll") for (int m = 0; m < 4; ++m) _Pragma("unroll") for (int n = 0; n < 2; ++n) _Pragma("unroll") for (int k = 0; k < 2; ++k) \
        acc[ai][bj][m][n] = __builtin_bit_cast(f32x4, __builtin_amdgcn_mfma_i32_16x16x64_i8(__builtin_bit_cast(i32x4, Bt[n][k]), __builtin_bit_cast(i32x4, At[m][k]), __builtin_bit_cast(i32x4, acc[ai][bj][m][n]), 0, 0, 0)); __builtin_amdgcn_s_setprio(0); } while (0)
#define PG8_WAIT_V(n) asm volatile("s_waitcnt vmcnt(" #n ")" ::: "memory")
#define PG8_WAIT_L(n) asm volatile("s_waitcnt lgkmcnt(" #n ")" ::: "memory")
#define PG8_BAR __builtin_amdgcn_s_barrier()
#define PG8_SCHED __builtin_amdgcn_sched_barrier(0)
#define PG8_KLOOP(MMA) \
        for (int t = 0; t < nt; t += 2) { \
            const bool last = (t == nt - 2); \
            const char* a1 = cA + (size_t)(t + 1) * kstep; \
            const char* a2 = last ? nA : cA + (size_t)(t + 2) * kstep; const char* b2 = last ? nB : cB + (size_t)(t + 2) * kstep; \
            const char* a3 = a2 + kstep; const char* b3 = b2 + kstep; \
            PG8_LDB(B0, 0, 0); PG8_LDB(B1, 0, 1); PG8_SCHED; PG8_LDA(At, 0, 0); PG8_STAGE(PG8_SA(1, 1), a1 + hstepA, voffA, hstepA); \
            PG8_WAIT_V(8); PG8_WAIT_L(0); PG8_BAR; MMA(0, 0, At, B0); MMA(0, 1, At, B1); PG8_BAR; PG8_SCHED; \
            PG8_LDA(At, 0, 1); PG8_STAGE(PG8_SB(0, 0), b2, voffB, hstepB); PG8_STAGE(PG8_SB(0, 1), b2 + hstepB, voffB, hstepB); PG8_STAGE(PG8_SA(0, 0), a2, voffA, hstepA); \
            PG8_WAIT_V(8); PG8_WAIT_L(0); PG8_BAR; MMA(1, 0, At, B0); MMA(1, 1, At, B1); PG8_BAR; PG8_SCHED; \
            PG8_LDB(B0, 1, 0); PG8_LDB(B1, 1, 1); PG8_SCHED; PG8_LDA(At, 1, 0); PG8_STAGE(PG8_SA(0, 1), a2 + hstepA, voffA, hstepA); \
            PG8_WAIT_V(8); PG8_WAIT_L(0); PG8_BAR; MMA(0, 0, At, B0); MMA(0, 1, At, B1); PG8_BAR; PG8_SCHED; \
            PG8_LDA(At, 1, 1); PG8_STAGE(PG8_SB(1, 0), b3, voffB, hstepB); PG8_STAGE(PG8_SB(1, 1), b3 + hstepB, voffB, hstepB); PG8_STAGE(PG8_SA(1, 0), a3, voffA, hstepA); \
            PG8_WAIT_V(8); PG8_WAIT_L(0); PG8_BAR; MMA(1, 0, At, B0); MMA(1, 1, At, B1); PG8_BAR; PG8_SCHED; \
        }

    Unit cur, nxt; int ui = 0;
    if (!S.next(0, cur)) return;
    f32x4 acc[2][2][4][2];
    E.init(acc, cur, wr, wc, fr, fq);
    bf16x8 At[4][2], B0[2][2], B1[2][2];
    const char* cA = cur.A; const char* cB = cur.B;
    PG8_STAGE(PG8_SB(0, 0), cB, voffB, hstepB); PG8_STAGE(PG8_SB(0, 1), cB + hstepB, voffB, hstepB); PG8_STAGE(PG8_SA(0, 0), cA, voffA, hstepA); PG8_STAGE(PG8_SA(0, 1), cA + hstepA, voffA, hstepA);
    PG8_STAGE(PG8_SB(1, 0), cB + kstep, voffB, hstepB); PG8_STAGE(PG8_SA(1, 0), cA + kstep, voffA, hstepA); PG8_STAGE(PG8_SB(1, 1), cB + hstepB + kstep, voffB, hstepB);
    PG8_WAIT_V(6);
    if (wr == 1) PG8_BAR;
    PG8_BAR;
    for (;;) {
        const bool has_next = S.next(ui + 1, nxt);
        const char* nA = has_next ? nxt.A : cA; const char* nB = has_next ? nxt.B : cB;
        const int nt = cur.nt;
        if constexpr (Epi::F8GATE) {
            if (!(cur.kind & 1)) { PG8_KLOOP(PG8_MMA8) if (wr == 0) PG8_BAR; E.template epi<0>(acc, cur, wr, wc); }
            else { PG8_KLOOP(PG8_MMA) if (wr == 0) PG8_BAR; E.template epi<1>(acc, cur, wr, wc); }
            if (!has_next) break; E.init(acc, nxt, wr, wc, fr, fq);
        } else {
        if constexpr (Epi::I8) { PG8_KLOOP(PG8_MMA8) } else { PG8_KLOOP(PG8_MMA) }
        if (wr == 0) PG8_BAR;
        if constexpr (Epi::FUSED_INIT) { E.epi_init(acc, cur, nxt, has_next, wr, wc, fr, fq); if (!has_next) break; }
        else { E(acc, cur, wr, wc, fr, fq); if (!has_next) break; E.init(acc, nxt, wr, wc, fr, fq); }
        }
        cur = nxt; cA = nA; cB = nB; ++ui;
        if (wr == 1) PG8_BAR;
    }
    PG8_WAIT_V(0);
    PG8_BAR;
#undef PG8_SA
#undef PG8_SB
#undef PG8_STAGE
#undef PG8_LDA
#undef PG8_LDB
#undef PG8_MMA
#undef PG8_MMA8
#undef PG8_KLOOP
#undef PG8_WAIT_V
#undef PG8_WAIT_L
#undef PG8_BAR
#undef PG8_SCHED
}

__device__ __forceinline__ float row_rstd(const float* rsp, int row) {
    const f32x4 a = *(const f32x4*)(rsp + (size_t)row * 8), b = *(const f32x4*)(rsp + (size_t)row * 8 + 4);
    const float ssum = ((a[0] + a[1]) + (a[2] + a[3])) + ((b[0] + b[1]) + (b[2] + b[3]));
    return 1.0f / sqrtf(ssum * (1.f / DM) + EPS);
}
__device__ __forceinline__ void rows_rstd(const float* rsp, int row0, float (&rs)[2][4]) {
    f32x4 a[2][4], b[2][4];
#pragma unroll
    for (int ai = 0; ai < 2; ++ai)
#pragma unroll
        for (int m = 0; m < 4; ++m) { const float* p = rsp + (size_t)(row0 + ai * HALF + m * 16) * 8; a[ai][m] = *(const f32x4*)p; b[ai][m] = *(const f32x4*)(p + 4); }
#pragma unroll
    for (int ai = 0; ai < 2; ++ai)
#pragma unroll
        for (int m = 0; m < 4; ++m) { const float ssum = ((a[ai][m][0] + a[ai][m][1]) + (a[ai][m][2] + a[ai][m][3])) + ((b[ai][m][0] + b[ai][m][1]) + (b[ai][m][2] + b[ai][m][3]));
            rs[ai][m] = __builtin_amdgcn_rsqf(ssum * (1.f / DM) + EPS); }
}
__device__ __forceinline__ void rows_sx(const float* rsq, float* xqs, int row0, bool rec, float (&sx)[2][4]) {
    f32x4 a[2][4], b[2][4];
#pragma unroll
    for (int ai = 0; ai < 2; ++ai)
#pragma unroll
        for (int m = 0; m < 4; ++m) { const float* p = rsq + (size_t)(row0 + ai * HALF + m * 16) * 8; a[ai][m] = *(const f32x4*)p; b[ai][m] = *(const f32x4*)(p + 4); }
#pragma unroll
    for (int ai = 0; ai < 2; ++ai)
#pragma unroll
        for (int m = 0; m < 4; ++m) { const float amax = fmaxf(fmaxf(fmaxf(a[ai][m][0], a[ai][m][1]), fmaxf(a[ai][m][2], a[ai][m][3])), fmaxf(fmaxf(b[ai][m][0], b[ai][m][1]), fmaxf(b[ai][m][2], b[ai][m][3])));
            const float dx = xq_dx(amax); sx[ai][m] = __builtin_amdgcn_rcpf(dx); if (rec) xqs[row0 + ai * HALF + m * 16] = dx; }
}
__device__ __forceinline__ void zero_acc(f32x4 (&acc)[2][2][4][2]) {
#pragma unroll
    for (int a = 0; a < 2; ++a)
#pragma unroll
        for (int b = 0; b < 2; ++b)
#pragma unroll
            for (int m = 0; m < 4; ++m)
#pragma unroll
                for (int n = 0; n < 2; ++n) acc[a][b][m][n] = (f32x4){0.f, 0.f, 0.f, 0.f};
}
struct EpiP {
    static constexpr bool PERM = true, FUSED_INIT = false, F8GATE = false, I8 = false;
    bf16* P; const float* cs; const float* rsp;
    __device__ __forceinline__ void init(f32x4 (&acc)[2][2][4][2], const Unit&, int, int, int, int) const { zero_acc(acc); }
    __device__ __forceinline__ void operator()(const f32x4 (&acc)[2][2][4][2], const Unit& u, int wr, int wc, int fr, int fq) const {
        const int row0 = u.pm * BM + wr * 64 + fr, col0 = u.pn * BM + wc * 32 + 8 * fq;
        const int mode = u.pn < 4 ? 1 : ((u.pn >= 10 && u.pn < 14) ? 2 : 0);
        float rsv[2][4]; rows_rstd(rsp, row0, rsv);
#pragma unroll
        for (int ai = 0; ai < 2; ++ai)
#pragma unroll
            for (int m = 0; m < 4; ++m) { const int row = row0 + ai * HALF + m * 16; bf16* rowp = P + (size_t)row * INW + col0;
                f32x4 c01 = (f32x4){1.f, 0.f, 1.f, 0.f}, c23 = c01;
                if (mode == 2) { const f32x4* t = (const f32x4*)(cs + ((size_t)(row & (SEQ - 1)) * 64 + wc * 16 + 4 * fq) * 2); c01 = t[0]; c23 = t[1]; }
                const float rs = rsv[ai][m];
#pragma unroll
                for (int bj = 0; bj < 2; ++bj) { f32x4 v0 = acc[ai][bj][m][0] * rs, v1 = acc[ai][bj][m][1] * rs;
                    if (mode == 1) {
#pragma unroll
                        for (int j = 0; j < 4; ++j) { v0[j] = gelu_tanh(v0[j]); v1[j] = gelu_tanh(v1[j]); } }
                    else if (mode == 2) {
                        const f32x4 a = v0, b = v1;
                        v0[0] = a[0] * c01[0] - a[1] * c01[1]; v0[1] = a[1] * c01[0] + a[0] * c01[1];
                        v0[2] = a[2] * c01[2] - a[3] * c01[3]; v0[3] = a[3] * c01[2] + a[2] * c01[3];
                        v1[0] = b[0] * c23[0] - b[1] * c23[1]; v1[1] = b[1] * c23[0] + b[0] * c23[1];
                        v1[2] = b[2] * c23[2] - b[3] * c23[3]; v1[3] = b[3] * c23[2] + b[2] * c23[3]; }
                    u32x4 w; w.x = cvtpk(v0[0], v0[1]); w.y = cvtpk(v0[2], v0[3]); w.z = cvtpk(v1[0], v1[1]); w.w = cvtpk(v1[2], v1[3]);
                    *(u32x4*)(rowp + bj * HALF) = w; } }
    }
};
struct EpiResBf {
    static constexpr bool PERM = true, FUSED_INIT = true, F8GATE = false, I8 = false;
    bf16* X; float* rsp; LAS float* red; unsigned char* XQ; const float* rsq; float* xqs; float* mxp; LAS float* redm;
    __device__ __forceinline__ void init(f32x4 (&acc)[2][2][4][2], const Unit& u, int wr, int wc, int fr, int fq) const {
        const int row0 = u.pm * BM + wr * 64 + fr, col0 = u.pn * BM + wc * 32 + 8 * fq;
#pragma unroll
        for (int ai = 0; ai < 2; ++ai)
#pragma unroll
            for (int m = 0; m < 4; ++m) { const bf16* rowp = X + (size_t)(row0 + ai * HALF + m * 16) * DM + col0;
#pragma unroll
                for (int bj = 0; bj < 2; ++bj) { const u32x4 w = *(const u32x4*)(rowp + bj * HALF);
                    acc[ai][bj][m][0] = (f32x4){bf_lo(w.x), bf_hi(w.x), bf_lo(w.y), bf_hi(w.y)}; acc[ai][bj][m][1] = (f32x4){bf_lo(w.z), bf_hi(w.z), bf_lo(w.w), bf_hi(w.w)}; } }
    }
    __device__ __forceinline__ void operator()(const f32x4 (&acc)[2][2][4][2], const Unit& u, int wr, int wc, int fr, int fq) const {
        const int row0 = u.pm * BM + wr * 64 + fr, col0 = u.pn * BM + wc * 32 + 8 * fq;
        float sxv[2][4] = {};
        if (XQ) rows_sx(rsq, xqs, row0, (fq == 0) && (wc == 0) && (u.pn == 0), sxv);
#pragma unroll
        for (int ai = 0; ai < 2; ++ai)
#pragma unroll
            for (int m = 0; m < 4; ++m) { bf16* rowp = X + (size_t)(row0 + ai * HALF + m * 16) * DM + col0; float sq = 0.f, am = 0.f;
#pragma unroll
                for (int bj = 0; bj < 2; ++bj) { const f32x4 v0 = acc[ai][bj][m][0], v1 = acc[ai][bj][m][1];
                    u32x4 w; w.x = cvtpk(v0[0], v0[1]); w.y = cvtpk(v0[2], v0[3]); w.z = cvtpk(v1[0], v1[1]); w.w = cvtpk(v1[2], v1[3]);
                    *(u32x4*)(rowp + bj * HALF) = w;
                    am = fmaxf(am, fmaxf(fmaxf(fmaxf(fabsf(v0[0]), fabsf(v0[1])), fmaxf(fabsf(v0[2]), fabsf(v0[3]))), fmaxf(fmaxf(fabsf(v1[0]), fabsf(v1[1])), fmaxf(fabsf(v1[2]), fabsf(v1[3])))));
                    if (XQ) { u32x2 q8; q8.x = quant4_i8(v0[0], v0[1], v0[2], v0[3], sxv[ai][m]); q8.y = quant4_i8(v1[0], v1[1], v1[2], v1[3], sxv[ai][m]);
                        *(u32x2*)(XQ + (size_t)(row0 + ai * HALF + m * 16) * XQP + col0 + bj * HALF) = q8; }
                    sq += (bf_lo(w.x) * bf_lo(w.x) + bf_hi(w.x) * bf_hi(w.x)) + (bf_lo(w.y) * bf_lo(w.y) + bf_hi(w.y) * bf_hi(w.y));
                    sq += (bf_lo(w.z) * bf_lo(w.z) + bf_hi(w.z) * bf_hi(w.z)) + (bf_lo(w.w) * bf_lo(w.w) + bf_hi(w.w) * bf_hi(w.w)); }
                { const int ln = fr | (fq << 4); sq += shfl_x(sq, 16, ln); sq += shfl_x(sq, 32, ln); am = fmaxf(am, shfl_x(am, 16, ln)); am = fmaxf(am, shfl_x(am, 32, ln)); }
                if (fq == 0) { red[(ai * HALF + wr * 64 + m * 16 + fr) * 4 + wc] = sq; redm[(ai * HALF + wr * 64 + m * 16 + fr) * 4 + wc] = am; } }
        asm volatile("s_waitcnt lgkmcnt(0)" ::: "memory"); __builtin_amdgcn_s_barrier(); asm volatile("" ::: "memory");
        const int t = opaque_tid();
        if (t < 256) { const f32x4 r4 = *(const LAS f32x4*)(red + t * 4); rsp[((size_t)u.pm * BM + t) * 8 + u.pn] = (r4[0] + r4[1]) + (r4[2] + r4[3]);
            const f32x4 m4 = *(const LAS f32x4*)(redm + t * 4); mxp[((size_t)u.pm * BM + t) * 8 + u.pn] = fmaxf(fmaxf(m4[0], m4[1]), fmaxf(m4[2], m4[3])); }
    }
    __device__ __forceinline__ void epi_init(f32x4 (&acc)[2][2][4][2], const Unit& u, const Unit& nx, bool has_next, int wr, int wc, int fr, int fq) const {
        const int row0 = u.pm * BM + wr * 64 + fr, col0 = u.pn * BM + wc * 32 + 8 * fq;
        const int nrow0 = nx.pm * BM + wr * 64 + fr, ncol0 = nx.pn * BM + wc * 32 + 8 * fq;
        float sxv[2][4] = {};
        if (XQ) rows_sx(rsq, xqs, row0, (fq == 0) && (wc == 0) && (u.pn == 0), sxv);
#pragma unroll
        for (int ai = 0; ai < 2; ++ai)
#pragma unroll
            for (int m = 0; m < 4; ++m) { bf16* rowp = X + (size_t)(row0 + ai * HALF + m * 16) * DM + col0; float sq = 0.f, am = 0.f;
#pragma unroll
                for (int bj = 0; bj < 2; ++bj) { const f32x4 v0 = acc[ai][bj][m][0], v1 = acc[ai][bj][m][1];
                    u32x4 w; w.x = cvtpk(v0[0], v0[1]); w.y = cvtpk(v0[2], v0[3]); w.z = cvtpk(v1[0], v1[1]); w.w = cvtpk(v1[2], v1[3]);
                    *(u32x4*)(rowp + bj * HALF) = w;
                    am = fmaxf(am, fmaxf(fmaxf(fmaxf(fabsf(v0[0]), fabsf(v0[1])), fmaxf(fabsf(v0[2]), fabsf(v0[3]))), fmaxf(fmaxf(fabsf(v1[0]), fabsf(v1[1])), fmaxf(fabsf(v1[2]), fabsf(v1[3])))));
                    if (XQ) { u32x2 q8; q8.x = quant4_i8(v0[0], v0[1], v0[2], v0[3], sxv[ai][m]); q8.y = quant4_i8(v1[0], v1[1], v1[2], v1[3], sxv[ai][m]);
                        *(u32x2*)(XQ + (size_t)(row0 + ai * HALF + m * 16) * XQP + col0 + bj * HALF) = q8; }
                    sq += (bf_lo(w.x) * bf_lo(w.x) + bf_hi(w.x) * bf_hi(w.x)) + (bf_lo(w.y) * bf_lo(w.y) + bf_hi(w.y) * bf_hi(w.y));
                    sq += (bf_lo(w.z) * bf_lo(w.z) + bf_hi(w.z) * bf_hi(w.z)) + (bf_lo(w.w) * bf_lo(w.w) + bf_hi(w.w) * bf_hi(w.w)); }
                { const int ln = fr | (fq << 4); sq += shfl_x(sq, 16, ln); sq += shfl_x(sq, 32, ln); am = fmaxf(am, shfl_x(am, 16, ln)); am = fmaxf(am, shfl_x(am, 32, ln)); }
                if (fq == 0) { red[(ai * HALF + wr * 64 + m * 16 + fr) * 4 + wc] = sq; redm[(ai * HALF + wr * 64 + m * 16 + fr) * 4 + wc] = am; }
                if (has_next) { const bf16* nrowp = X + (size_t)(nrow0 + ai * HALF + m * 16) * DM + ncol0;
#pragma unroll
                    for (int bj = 0; bj < 2; ++bj) { const u32x4 w = *(const u32x4*)(nrowp + bj * HALF);
                        acc[ai][bj][m][0] = (f32x4){bf_lo(w.x), bf_hi(w.x), bf_lo(w.y), bf_hi(w.y)}; acc[ai][bj][m][1] = (f32x4){bf_lo(w.z), bf_hi(w.z), bf_lo(w.w), bf_hi(w.w)}; } } }
        asm volatile("s_waitcnt lgkmcnt(0)" ::: "memory"); __builtin_amdgcn_s_barrier(); asm volatile("" ::: "memory");
        const int t = opaque_tid();
        if (t < 256) { const f32x4 r4 = *(const LAS f32x4*)(red + t * 4); rsp[((size_t)u.pm * BM + t) * 8 + u.pn] = (r4[0] + r4[1]) + (r4[2] + r4[3]);
            const f32x4 m4 = *(const LAS f32x4*)(redm + t * 4); mxp[((size_t)u.pm * BM + t) * 8 + u.pn] = fmaxf(fmaxf(m4[0], m4[1]), fmaxf(m4[2], m4[3])); }
    }
};
struct EpiSwiglu {
    static constexpr bool PERM = true, FUSED_INIT = false, F8GATE = false, I8 = true;
    bf16* H; const float* rsp; const float* xqs; const unsigned* cmax;
    __device__ __forceinline__ void init(f32x4 (&acc)[2][2][4][2], const Unit&, int, int, int, int) const { zero_acc(acc); }
    __device__ __forceinline__ void operator()(const f32x4 (&acc)[2][2][4][2], const Unit& u, int wr, int wc, int fr, int fq) const {
        const int row0 = u.pm * BM + wr * 64 + fr, col0 = u.pn * HALF + wc * 32 + 8 * fq;
        float dxv[2][4];
#pragma unroll
        for (int ai = 0; ai < 2; ++ai)
#pragma unroll
            for (int m = 0; m < 4; ++m) dxv[ai][m] = xqs[row0 + ai * HALF + m * 16];
        f32x4 d1[2], d3[2], nd1[2], id13[2];
#pragma unroll
        for (int n = 0; n < 2; ++n) { const u32x4 u1 = *(const u32x4*)(cmax + col0 + 4 * n), u3 = *(const u32x4*)(cmax + DFF + col0 + 4 * n);
#pragma unroll
            for (int j = 0; j < 4; ++j) { d1[n][j] = __builtin_bit_cast(float, u1[j]) * (1.0f / 127.0f); d3[n][j] = __builtin_bit_cast(float, u3[j]) * (1.0f / 127.0f);
                nd1[n][j] = d1[n][j] * (-LOG2E); id13[n][j] = __builtin_amdgcn_rcpf(d1[n][j] * d3[n][j]); } }
        float rsv[2][4]; rows_rstd(rsp, row0, rsv);
#pragma unroll
        for (int ai = 0; ai < 2; ++ai)
#pragma unroll
            for (int m = 0; m < 4; ++m) { const int row = row0 + ai * HALF + m * 16; bf16* rowp = H + (size_t)row * DFF + col0;
                const float ra = rsv[ai][m] * dxv[ai][m], ira2 = __builtin_amdgcn_rcpf(ra * ra);
                f32x4 h0, h1;
                const f32x4 av = __builtin_convertvector(__builtin_bit_cast(i32x4, acc[ai][0][m][0]), f32x4), bv = __builtin_convertvector(__builtin_bit_cast(i32x4, acc[ai][0][m][1]), f32x4);
                const f32x4 cav = __builtin_convertvector(__builtin_bit_cast(i32x4, acc[ai][1][m][0]), f32x4), cbv = __builtin_convertvector(__builtin_bit_cast(i32x4, acc[ai][1][m][1]), f32x4);
#pragma unroll
                for (int j = 0; j < 4; ++j) { const float a = av[j], b = bv[j], ca = cav[j], cb = cbv[j];
                    const float ea = __builtin_amdgcn_exp2f(a * (ra * nd1[0][j])), eb = __builtin_amdgcn_exp2f(b * (ra * nd1[1][j]));
                    const float ia = ira2 * id13[0][j], ib = ira2 * id13[1][j];
                    h0[j] = (a * ca) * __builtin_amdgcn_rcpf(__builtin_fmaf(ea, ia, ia)); h1[j] = (b * cb) * __builtin_amdgcn_rcpf(__builtin_fmaf(eb, ib, ib)); }
                u32x4 w; w.x = cvtpk(h0[0], h0[1]); w.y = cvtpk(h0[2], h0[3]); w.z = cvtpk(h1[0], h1[1]); w.w = cvtpk(h1[2], h1[3]);
                *(u32x4*)rowp = w; }
    }
};
struct EpiGate {
    static constexpr bool PERM = true, FUSED_INIT = false, F8GATE = true, I8 = false;
    bf16* Y; const float* bgate; char* scr; const float* rsp; LAS u32x4* sst; LAS u32x4* yst; const float* xqs; const unsigned* wmax;
#ifndef GATE_NG
#define GATE_NG 7
#endif
    static constexpr int NG = GATE_NG;
    static_assert(NG >= 7 && NG <= 8, "the LDS slot holds one row group per lane");
    mutable unsigned sq[4 * NG];
    __device__ __forceinline__ void init(f32x4 (&acc)[2][2][4][2], const Unit&, int, int, int, int) const { zero_acc(acc); }
    template <int BR>
    __device__ __forceinline__ void epi(const f32x4 (&acc)[2][2][4][2], const Unit& u, int wr, int wc) const {
        const int tid = opaque_tid(), seg = u.kind, k = seg >> 1, fr = tid & 15, fq = (tid >> 4) & 3;
        u32x4* Ya = (u32x4*)scr + tid; LAS u32x4* Sst = sst + tid;
        if constexpr (BR == 0) {
            const int bcol0 = u.pn * BM + wc * 32 + 8 * fq; f32x4 bv[2][2];
#pragma unroll
            for (int bj = 0; bj < 2; ++bj)
#pragma unroll
                for (int n = 0; n < 2; ++n) bv[bj][n] = *(const f32x4*)(bgate + k * DM + bcol0 + bj * HALF + 4 * n) * (-LOG2E) - 7.994353436858858f;
            float dxv[2][4];
#pragma unroll
            for (int ai = 0; ai < 2; ++ai)
#pragma unroll
                for (int m = 0; m < 4; ++m) dxv[ai][m] = xqs[u.pm * BM + wr * 64 + fr + ai * HALF + m * 16];
            const float dw = __builtin_bit_cast(float, __hip_atomic_load(wmax + k, __ATOMIC_RELAXED, __HIP_MEMORY_SCOPE_AGENT)) * (-LOG2E / 127.0f);
            float rsv[2][4]; rows_rstd(rsp, u.pm * BM + wr * 64 + fr, rsv);
            unsigned st1[4 * (8 - NG) + 4];
#pragma unroll
            for (int ai = 0; ai < 2; ++ai)
#pragma unroll
                for (int m = 0; m < 4; ++m) { const float rs = rsv[ai][m] * dxv[ai][m] * dw;
#pragma unroll
                    for (int bj = 0; bj < 2; ++bj) { const int j = (ai * 4 + m) * 2 + bj;
#pragma unroll
                        for (int n = 0; n < 2; ++n) { const f32x4 v = __builtin_convertvector(__builtin_bit_cast(i32x4, acc[ai][bj][m][n]), f32x4) * rs + bv[bj][n]; unsigned w = 0u;
                            w = __builtin_amdgcn_cvt_pk_u8_f32(sig255(v[0]), 0u, w); w = __builtin_amdgcn_cvt_pk_u8_f32(sig255(v[1]), 1u, w);
                            w = __builtin_amdgcn_cvt_pk_u8_f32(sig255(v[2]), 2u, w); w = __builtin_amdgcn_cvt_pk_u8_f32(sig255(v[3]), 3u, w);
                            if (ai * 4 + m < NG) sq[2 * j + n] = w; else st1[2 * j + n - 4 * NG] = w; } } }
#pragma unroll
            for (int c = 0; c < 8 - NG; ++c) Sst[c * NTHR] = (u32x4){st1[4 * c], st1[4 * c + 1], st1[4 * c + 2], st1[4 * c + 3]};
        } else {
            auto body = [&](auto KCt) { constexpr int KC = decltype(KCt)::value;
            const int row0 = u.pm * BM + wr * 64 + fr, col0 = u.pn * BM + wc * 32 + 8 * fq;
#pragma unroll
            for (int ai = 0; ai < 2; ++ai) {
                u32x4 yv[8]; u32x4 sv[4];
#pragma unroll
                for (int m = 0; m < 4; ++m) if (ai * 4 + m >= NG) sv[m] = Sst[(ai * 4 + m - NG) * NTHR];
                if constexpr (KC > 0) {
#pragma unroll
                    for (int q = 0; q < 8; ++q) yv[q] = (ai == 1 && q >= 6) ? yst[(q - 6) * NTHR + tid] : Ya[(ai * 8 + q) * NTHR]; }
#pragma unroll
                for (int m = 0; m < 4; ++m)
#pragma unroll
                    for (int bj = 0; bj < 2; ++bj) { const int q = m * 2 + bj, j = (ai * 4 + m) * 2 + bj; const unsigned s0 = (ai * 4 + m < NG) ? sq[2 * j] : sv[m][2 * bj], s1 = (ai * 4 + m < NG) ? sq[2 * j + 1] : sv[m][2 * bj + 1];
                        f32x4 z0, z1;
                        f32x4 y0 = (f32x4){0.f, 0.f, 0.f, 0.f}, y1 = y0;
                        if constexpr (KC > 0) { const u32x4 y = yv[q]; y0 = (f32x4){bf_lo(y.x), bf_hi(y.x), bf_lo(y.y), bf_hi(y.y)}; y1 = (f32x4){bf_lo(y.z), bf_hi(y.z), bf_lo(y.w), bf_hi(y.w)}; }
                        z0[0] = __builtin_fmaf((float)(s0 & 0xffu), acc[ai][bj][m][0][0], y0[0]); z0[1] = __builtin_fmaf((float)((s0 >> 8) & 0xffu), acc[ai][bj][m][0][1], y0[1]);
                        z0[2] = __builtin_fmaf((float)((s0 >> 16) & 0xffu), acc[ai][bj][m][0][2], y0[2]); z0[3] = __builtin_fmaf((float)(s0 >> 24), acc[ai][bj][m][0][3], y0[3]);
                        z1[0] = __builtin_fmaf((float)(s1 & 0xffu), acc[ai][bj][m][1][0], y1[0]); z1[1] = __builtin_fmaf((float)((s1 >> 8) & 0xffu), acc[ai][bj][m][1][1], y1[1]);
                        z1[2] = __builtin_fmaf((float)((s1 >> 16) & 0xffu), acc[ai][bj][m][1][2], y1[2]); z1[3] = __builtin_fmaf((float)(s1 >> 24), acc[ai][bj][m][1][3], y1[3]);
                        u32x4 w; w.x = cvtpk(z0[0], z0[1]); w.y = cvtpk(z0[2], z0[3]); w.z = cvtpk(z1[0], z1[1]); w.w = cvtpk(z1[2], z1[3]);
                        if constexpr (KC < 2) { if (ai == 1 && q >= 6) yst[(q - 6) * NTHR + tid] = w; else Ya[(ai * 8 + q) * NTHR] = w; }
                        else *(u32x4*)(Y + (size_t)(row0 + ai * HALF + m * 16) * DM + col0 + bj * HALF) = w; }
                asm volatile("" ::: "memory"); }
            };
            if (k == 0) body(std::integral_constant<int, 0>{}); else if (k == 3) body(std::integral_constant<int, 2>{}); else body(std::integral_constant<int, 1>{});
        }
    }
};
}

namespace att {
constexpr int D = 128, NW = 8, QBLK = 32, KVBLK = 64, QB = NW * QBLK;
constexpr int PQ = INW, PO = DM;
constexpr float SCALE = 0.08838834764831845f;
constexpr float THR = 8.f;
constexpr int SHM_V = KVBLK * D * 2, SHM_K = KVBLK * D * 2;
constexpr int OFF_WS = 2 * SHM_V + 2 * SHM_K;
constexpr int OFF_SEL = OFF_WS + NW * 64 * 4;
constexpr int OFF_KMEAN = OFF_SEL + 2 * 256 * 4;
constexpr int OFF_PART = OFF_KMEAN + 8 * 128 * 4;
#define KSWZ(row, colB) ((row) * 256 + ((colB) ^ (((row) & 7) << 4)))
__device__ __forceinline__ int v_st(int k, int c) { const int kk = (k & ~0xC) | ((k & 4) << 1) | ((k & 8) >> 1); return ((kk >> 3) * 4 + (c >> 5)) * 512 + ((kk & 7) * 32 + (c & 31)) * 2; }
__device__ __forceinline__ int v_rd_base(int lane) { return ((lane & 3) << 3) | (((lane >> 2) & 3) << 6) | (((lane >> 4) & 1) << 5) | (((lane >> 5) & 1) << 8); }
constexpr int v_rd_off(int d0, int ks, int half) { return d0 * 512 + ks * 4096 + half * 2048; }
__device__ __forceinline__ int crow(int r, int hi) { return (r & 3) + 8 * (r >> 2) + 4 * hi; }
__device__ __forceinline__ bf16x8 load8(const bf16* p) { return *reinterpret_cast<const bf16x8*>(p); }
__device__ __forceinline__ void mask_tile(f32x16& p0, f32x16& p1, int dq) {
    const float NEG = -__builtin_inff();
#pragma unroll
    for (int r = 0; r < 16; ++r) {
        const int c = (r & 3) + 8 * (r >> 2);
        if (dq - c < 0) p0[r] = NEG;
        if (dq - c - 32 < 0) p1[r] = NEG;
    }
}
__device__ __forceinline__ void partialSM(f32x16& p0, f32x16& p1, float& m_reg, float& mn, float& alpha) {
    float pmax = p0[0]; for (int r = 1; r < 16; ++r) pmax = fmaxf(pmax, p0[r]); for (int r = 0; r < 16; ++r) pmax = fmaxf(pmax, p1[r]);
    { auto rr = __builtin_amdgcn_permlane32_swap(__float_as_uint(pmax), __float_as_uint(pmax), false, false);
      pmax = fmaxf(__uint_as_float(rr[0]), __uint_as_float(rr[1])); }
    constexpr float C2 = 1.4426950408889634f * SCALE;
    if (__builtin_expect(__all((pmax - m_reg) * SCALE <= THR), 1)) { mn = m_reg; alpha = 1.f; }
    else { mn = fmaxf(m_reg, pmax); alpha = __builtin_amdgcn_exp2f((m_reg - mn) * C2); m_reg = mn; }
    const float mnL = -mn * C2;
    for (int r = 0; r < 16; ++r) p0[r] = fmaf(p0[r], C2, mnL); for (int r = 0; r < 16; ++r) p1[r] = fmaf(p1[r], C2, mnL);
    for (int r = 0; r < 16; ++r) p0[r] = __builtin_amdgcn_exp2f(p0[r]);
}
__device__ __forceinline__ void finishSM(f32x16& p0, f32x16& p1, float alpha, float& l_reg, bf16x8& pa0, bf16x8& pa1, bf16x8& pa2, bf16x8& pa3) {
    for (int r = 0; r < 16; ++r) p1[r] = __builtin_amdgcn_exp2f(p1[r]);
    float ps = 0; for (int r = 0; r < 16; ++r) ps += p0[r]; for (int r = 0; r < 16; ++r) ps += p1[r];
    { auto rr = __builtin_amdgcn_permlane32_swap(__float_as_uint(ps), __float_as_uint(ps), false, false);
      ps = __uint_as_float(rr[0]) + __uint_as_float(rr[1]); }
    l_reg = l_reg * alpha + ps;
#define PK4(P, B_, OUT) do { unsigned a0 = cvtpk(P[B_+0], P[B_+1]), a1 = cvtpk(P[B_+2], P[B_+3]);                          \
        unsigned b0 = cvtpk(P[B_+4], P[B_+5]), b1 = cvtpk(P[B_+6], P[B_+7]);                                             \
        auto r0 = __builtin_amdgcn_permlane32_swap(a0, b0, false, false); auto r1 = __builtin_amdgcn_permlane32_swap(a1, b1, false, false); \
        u32x4 w = {r0[0], r1[0], r0[1], r1[1]}; OUT = *reinterpret_cast<bf16x8*>(&w); } while (0)
    PK4(p0, 0, pa0); PK4(p0, 8, pa1); PK4(p1, 0, pa2); PK4(p1, 8, pa3);
#undef PK4
}
template <int KB>
__device__ __forceinline__ void qkt(f32x16& p0, f32x16& p1, const char* K_lds, int r32, int hi, const bf16x8* qr) {
    p0 = f32x16{}; p1 = f32x16{};
    const char* kb[4];
#pragma unroll
    for (int dd = 0; dd < 4; ++dd) kb[dd] = K_lds + KB * SHM_K + KSWZ(r32, (dd * 16 + hi * 8) * 2);
#pragma unroll
    for (int d0 = 0; d0 < 8; ++d0) { const char* a = kb[d0 & 3] + (d0 >> 2) * 128;
        bf16x8 b0 = *reinterpret_cast<const bf16x8*>(a);
        bf16x8 b1 = *reinterpret_cast<const bf16x8*>(a + 32 * 256);
        p0 = __builtin_amdgcn_mfma_f32_32x32x16_bf16(b0, qr[d0], p0, 0, 0, 0);
        p1 = __builtin_amdgcn_mfma_f32_32x32x16_bf16(b1, qr[d0], p1, 0, 0, 0); }
}
template <int VB>
__device__ __forceinline__ void pv_tile(f32x16* o, int vb0, bf16x8 pa0, bf16x8 pa1, bf16x8 pa2, bf16x8 pa3) {
#define TRRD(dst, off) asm volatile("ds_read_b64_tr_b16 %0, %1 offset:%2" : "=&v"(dst) : "v"(vb0), "i"(off) : "memory")
#define PV_D0(d0) do { s16x4 l0, l1, l2, l3, h0, h1, h2, h3; constexpr int b_ = VB * SHM_V + v_rd_off(d0, 0, 0); \
        TRRD(l0, b_); TRRD(h0, b_ + 2048); TRRD(l1, b_ + 4096); TRRD(h1, b_ + 6144); TRRD(l2, b_ + 8192); TRRD(h2, b_ + 10240); TRRD(l3, b_ + 12288); TRRD(h3, b_ + 14336); \
        asm volatile("s_waitcnt lgkmcnt(0)" ::: "memory"); SBAR();   \
        o[d0] = __builtin_amdgcn_mfma_f32_32x32x16_bf16(pa0, (bf16x8){l0[0], l0[1], l0[2], l0[3], h0[0], h0[1], h0[2], h0[3]}, o[d0], 0, 0, 0);   \
        o[d0] = __builtin_amdgcn_mfma_f32_32x32x16_bf16(pa1, (bf16x8){l1[0], l1[1], l1[2], l1[3], h1[0], h1[1], h1[2], h1[3]}, o[d0], 0, 0, 0);   \
        o[d0] = __builtin_amdgcn_mfma_f32_32x32x16_bf16(pa2, (bf16x8){l2[0], l2[1], l2[2], l2[3], h2[0], h2[1], h2[2], h2[3]}, o[d0], 0, 0, 0);   \
        o[d0] = __builtin_amdgcn_mfma_f32_32x32x16_bf16(pa3, (bf16x8){l3[0], l3[1], l3[2], l3[3], h3[0], h3[1], h3[2], h3[3]}, o[d0], 0, 0, 0); } while (0)
    PV_D0(0); PV_D0(1); PV_D0(2); PV_D0(3);
#undef PV_D0
#undef TRRD
}
struct Heads { const bf16* Q; const bf16* K; const bf16* V; bf16* O; };
struct BlockRef { int P0; int selix; };
struct Seam { bf16x8 qr[8]; bf16x8 st_v0, st_v1, st_k0, st_k1; };
#define ROW(p, k0, rr) ((p) + (size_t)((k0) + (rr)) * PQ + sc)
#define VMWN(n) asm volatile("s_waitcnt vmcnt(%0)" :: "i"(n) : "memory")
#define SLOAD_H(Kp, Vp, k0) do { S.st_v0 = load8(ROW(Vp, k0, sr)); S.st_v1 = load8(ROW(Vp, k0, 32 + sr));              \
                         S.st_k0 = load8(ROW(Kp, k0, sr)); S.st_k1 = load8(ROW(Kp, k0, 32 + sr)); } while (0)
#define SWRITE_HK(bf) do { *(bf16x8*)(K_lds + (bf) * SHM_K + kws) = S.st_k0; *(bf16x8*)(K_lds + (bf) * SHM_K + kws + 32 * 256) = S.st_k1; } while (0)
#define SWRITE_HV(bf) do { *(bf16x8*)(V_lds + (bf) * SHM_V + vst0) = S.st_v0; *(bf16x8*)(V_lds + (bf) * SHM_V + vst1) = S.st_v1; } while (0)
#define SWRITE_H(bf) do { SWRITE_HV(bf); SWRITE_HK(bf); } while (0)
__device__ __forceinline__ void moba_prime(const Heads& H, const BlockRef& cur, char* lds, Seam& S) {
    const int tid = opaque_tid(), wid = __builtin_amdgcn_readfirstlane(tid >> 6), lane = tid & 63, r32 = lane & 31, hi = lane >> 5;
    const int sr = tid >> 4, sc = (tid & 15) * 8, kws = KSWZ(sr, sc * 2); char* K_lds = lds + 2 * SHM_V;
    for (int d0 = 0; d0 < 8; ++d0) S.qr[d0] = load8(H.Q + (size_t)(cur.P0 + wid * QBLK + r32) * PQ + d0 * 16 + hi * 8);
    SLOAD_H(H.K, H.V, 0); VM_WAIT(); SWRITE_HK(0);
    __syncthreads();
}
__device__ __forceinline__ void moba_block(const Heads& H, const BlockRef& cur, const BlockRef& nxt, char* lds, Seam& S) {
    const int tid = opaque_tid(), wid = __builtin_amdgcn_readfirstlane(tid >> 6), lane = tid & 63, r32 = lane & 31, hi = lane >> 5;
    const int NT = (cur.P0 + QB) / KVBLK;
    const int qlo = cur.P0 + wid * QBLK, qm = qlo + r32 - 4 * hi;
    char* V_lds = lds; char* K_lds = lds + 2 * SHM_V;
    float* ws = (float*)(lds + OFF_WS) + wid * 64; float* li_l = ws, * al_l = ws + 32;
    const unsigned* selp = (const unsigned*)(lds + OFF_SEL) + cur.selix * 256 + wid * QBLK + r32;
    float m_reg = -1e30f, l_reg = 0; f32x16 o[4] = {};
    const int sr = tid >> 4, sc = (tid & 15) * 8, vst0 = v_st(sr, sc), vst1 = v_st(32 + sr, sc), kws = KSWZ(sr, sc * 2);
    const int vb0 = (int)(uintptr_t)V_lds + v_rd_base(lane);
    const bf16* Kh = H.K; const bf16* Vh = H.V;
#define RESC(a) do { if (__any((a) < 1.f)) { if (hi == 0) al_l[r32] = (a); asm volatile("s_waitcnt lgkmcnt(0)" ::: "memory");              \
                     for (int d_ = 0; d_ < 4; ++d_) for (int r = 0; r < 16; ++r) o[d_][r] *= al_l[crow(r, hi)]; } } while (0)
#define KBASE(t) ((t) * KVBLK)
#define MASKT(P0_, P1_, t) do { const int kb_ = KBASE(t); \
        if (kb_ < cur.P0) { if (!((*selp >> (kb_ >> 8)) & 1u)) { const float NEG_ = -__builtin_inff(); _Pragma("unroll") for (int r_ = 0; r_ < 16; ++r_) { P0_[r_] = NEG_; P1_[r_] = NEG_; } } } \
        else if (kb_ + KVBLK - 1 > qlo) mask_tile(P0_, P1_, qm - kb_); } while (0)
    constexpr int NQL = 8;
#define SEAM_K0() do { VMWN(NQL); SWRITE_HK(0); SBAR(); } while (0)
    f32x16 pA0, pA1, pB0, pB1; float mnA, mnB, alA, alB; bf16x8 pa0, pa1, pa2, pa3;
    SWRITE_HV(0); SBAR();
    if (NT > 1) { SLOAD_H(Kh, Vh, KBASE(1)); }
    SBAR(); qkt<0>(pA0, pA1, K_lds, r32, hi, S.qr);
    MASKT(pA0, pA1, 0); partialSM(pA0, pA1, m_reg, mnA, alA);
    if (NT > 1) { VM_WAIT(); SWRITE_H(1); }
    __syncthreads();
#define HALF_STEP(PX0, PX1, mnX, alX, PY0, PY1, alY, t, KB, VB, SB) do {                                                      \
        SBAR(); qkt<KB>(PX0, PX1, K_lds, r32, hi, S.qr);                                                          \
        finishSM(PY0, PY1, alY, l_reg, pa0, pa1, pa2, pa3); SBAR();                                                           \
        if ((t) + 1 < NT) { SLOAD_H(Kh, Vh, KBASE((t) + 1)); SBAR(); }                                               \
        pv_tile<VB>(o, vb0, pa0, pa1, pa2, pa3); MASKT(PX0, PX1, (t)); partialSM(PX0, PX1, m_reg, mnX, alX);                                        \
        __syncthreads();                                                                                                      \
        if ((t) + 1 < NT) { VM_WAIT(); SWRITE_H(SB); }                                                                          \
        RESC(alX); __syncthreads(); } while (0)
    for (int t = 1; t + 1 < NT; t += 2) {
        HALF_STEP(pB0, pB1, mnB, alB, pA0, pA1, alA, t, 1, 0, 0);
        HALF_STEP(pA0, pA1, mnA, alA, pB0, pB1, alB, t + 1, 0, 1, 1);
    }
    const bool even = (NT & 1) == 0;
    if (even) { SBAR(); qkt<1>(pB0, pB1, K_lds, r32, hi, S.qr); SBAR(); }
    SLOAD_H(Kh, Vh, 0); SBAR();
#pragma unroll
    for (int d0 = 0; d0 < 8; ++d0) S.qr[d0] = load8(H.Q + (size_t)(nxt.P0 + wid * QBLK + r32) * PQ + d0 * 16 + hi * 8);
    SBAR();
    finishSM(pA0, pA1, alA, l_reg, pa0, pa1, pa2, pa3); SBAR();
    pv_tile<0>(o, vb0, pa0, pa1, pa2, pa3);
    if (even) { MASKT(pB0, pB1, NT - 1); partialSM(pB0, pB1, m_reg, mnB, alB); __syncthreads(); RESC(alB);
        finishSM(pB0, pB1, alB, l_reg, pa0, pa1, pa2, pa3); SBAR(); pv_tile<1>(o, vb0, pa0, pa1, pa2, pa3); }
    SBAR(); SEAM_K0();
    if (hi == 0) li_l[r32] = l_reg; asm volatile("s_waitcnt lgkmcnt(0)" ::: "memory");
    float rli[16];
#pragma unroll
    for (int r = 0; r < 16; ++r) rli[r] = __builtin_amdgcn_rcpf(li_l[crow(r, hi)]);
    bf16* Ow = H.O + (size_t)(cur.P0 + wid * QBLK) * PO;
#pragma unroll
    for (int r = 0; r < 16; ++r) { const int orow = crow(r, hi);
#pragma unroll
        for (int d0 = 0; d0 < 4; ++d0) { const float v = o[d0][r] * rli[r];
            const float vn = shfl_x(v, 1, lane);
            if ((r32 & 1) == 0) *(unsigned*)(Ow + (size_t)orow * PO + d0 * 32 + r32) = cvtpk(v, vn); } }
    __syncthreads();
#undef RESC
#undef KBASE
#undef MASKT
#undef SEAM_K0
#undef HALF_STEP
}
#undef ROW
#undef VMWN
#undef SLOAD_H
#undef SWRITE_HK
#undef SWRITE_HV
#undef SWRITE_H
}

#define XB_TMO      128
#define XB_XCNT(j)  (256  + 64 * (j))
#define XB_XSUB(j)  (1280 + 64 * (j))
#define XB_XGEN(j)  (2304 + 64 * (j))
#define XB_TOP      3328
#define XB_TOPGEN   3392
#define XCD_BAR_WORDS 3456
#define XB_SPIN_CAP (1u << 18)
__device__ __forceinline__ unsigned xb_ld(unsigned* p)              { return __hip_atomic_load(p, __ATOMIC_RELAXED, __HIP_MEMORY_SCOPE_AGENT); }
__device__ __forceinline__ unsigned xb_add(unsigned* p, unsigned v) { return __hip_atomic_fetch_add(p, v, __ATOMIC_RELAXED, __HIP_MEMORY_SCOPE_AGENT); }
__device__ __forceinline__ unsigned xb_xcc_id() { return (unsigned)__builtin_amdgcn_s_getreg((3 << 11) | 20) & 0xFu; }
#define XB_SPIN(cond, bar) do { unsigned _sp = 0; while (cond) { __builtin_amdgcn_s_sleep(1); \
    if ((++_sp & 255u) == 0u) { if (xb_ld(&(bar)[XB_TMO])) break; if (_sp > XB_SPIN_CAP) { atomicAdd(&(bar)[XB_TMO], 1u); break; } } } } while (0)
struct XcdBarrier { unsigned* bar; unsigned x; volatile LAS unsigned* st; };
__device__ __forceinline__ XcdBarrier xcd_barrier_post(unsigned* bar, volatile LAS unsigned* st) {
    XcdBarrier b; b.bar = bar; b.x = xb_xcc_id(); b.st = st;
    if (threadIdx.x == 0) (void)xb_add(&bar[XB_XCNT(b.x)], 1u);
    return b;
}
__device__ __forceinline__ void xcd_barrier_complete(unsigned* bar, unsigned x, unsigned& nloc, unsigned& nx) {
    const unsigned G = gridDim.x * gridDim.y * gridDim.z;
    unsigned sum, cnt, mine, sp = 0u;
    for (;;) {
        sum = 0u; cnt = 0u; mine = 0u;
#pragma unroll
        for (unsigned j = 0; j < 16; ++j) { const unsigned c = xb_ld(&bar[XB_XCNT(j)]); sum += c; cnt += (c > 0u) ? 1u : 0u; mine = (j == x) ? c : mine; }
        if (sum == G) break;
        __builtin_amdgcn_s_sleep(1);
        if ((++sp & 255u) == 0u) { if (xb_ld(&bar[XB_TMO])) break; if (sp > XB_SPIN_CAP) { atomicAdd(&bar[XB_TMO], 1u); break; } }
    }
    nloc = mine > 0u ? mine : 1u; nx = cnt > 0u ? cnt : 1u;
}
__device__ __forceinline__ void xcd_barrier(const XcdBarrier& b) {
    asm volatile("s_waitcnt vmcnt(0)" ::: "memory");
    __syncthreads();
    if (threadIdx.x == 0) {
        unsigned* bar = b.bar;
        __builtin_amdgcn_s_waitcnt(0);
        unsigned nloc = b.st[0], nx = b.st[1];
        if (nloc == 0u) { xcd_barrier_complete(bar, b.x, nloc, nx); b.st[0] = nloc; b.st[1] = nx; }
        const unsigned old = xb_add(&bar[XB_XSUB(b.x)], 1u);
        const unsigned gen = old / nloc;
        if (old + 1u == (gen + 1u) * nloc) {
            __builtin_amdgcn_fence(__ATOMIC_RELEASE, "agent");
            asm volatile("s_waitcnt vmcnt(0)" ::: "memory");
            const unsigned og = xb_add(&bar[XB_TOP], 1u);
            const unsigned tg = og / nx;
            if (og + 1u == (tg + 1u) * nx) xb_add(&bar[XB_TOPGEN], 1u);
            else XB_SPIN(xb_ld(&bar[XB_TOPGEN]) == tg, bar);
            __builtin_amdgcn_fence(__ATOMIC_ACQUIRE, "agent");
            xb_add(&bar[XB_XGEN(b.x)], 1u);
            asm volatile("s_waitcnt vmcnt(0)" ::: "memory");
        } else {
            XB_SPIN(xb_ld(&bar[XB_XGEN(b.x)]) == gen, bar);
            __builtin_amdgcn_fence(__ATOMIC_ACQUIRE, "agent");
            asm volatile("s_waitcnt vmcnt(0)" ::: "memory");
        }
    }
    __syncthreads();
}

struct Args {
    const float* x; const float* g_mix; const float* w_in; const float* w_sgu; const float* b_sgu; const float* g_sgu; const float* w_sconv;
    const float* w_lru_conv; const float* b_lru_conv; const float* w_lru_a; const float* b_lru_a; const float* w_lru_x; const float* b_lru_x; const float* lru_lambda;
    const float* w_gate; const float* b_gate; const float* w_branch; const float* w_out; const float* g_ffn; const float* w_ffn1; const float* w_ffn3; const float* w_ffn2; const float* g_final;
    float* out; unsigned char* ws; int ph_lo, ph_hi, li, pad;
};
typedef const __attribute__((address_space(4))) Args* KA;
__device__ __forceinline__ KA opaque_ka(KA p) { asm volatile("" : "+s"(p)); return p; }

template <class RowMap>
__device__ __forceinline__ void transpose_item(const float* W, int ldw, bf16* dst, int ldd, int coff, const RowMap& rm, LAS float* scr, int k0, int n0, int lane, const float* gain = nullptr, const float scale = 1.0f) {
    const int rr = lane >> 4, c4 = (lane & 15) * 4;
    f32x4 v[16];
#pragma unroll
    for (int i = 0; i < 16; ++i) v[i] = *(const f32x4*)(W + (size_t)(k0 + 4 * i + rr) * ldw + n0 + c4);
#pragma unroll
    for (int i = 0; i < 16; ++i) { const int kk = 4 * i + rr; const float gk = (gain ? gain[k0 + kk] : 1.0f) * scale; LAS float* d = scr + kk * 65 + c4;
        d[0] = v[i][0] * gk; d[1] = v[i][1] * gk; d[2] = v[i][2] * gk; d[3] = v[i][3] * gk; }
    LDS_WAIT(); asm volatile("" ::: "memory");
    const int kc = (lane & 7) * 8;
#pragma unroll
    for (int j = 0; j < 8; ++j) { const int n = 8 * j + (lane >> 3); const LAS float* sp = scr + kc * 65 + n;
        u32x4 o; o.x = cvtpk(sp[0 * 65], sp[1 * 65]); o.y = cvtpk(sp[2 * 65], sp[3 * 65]); o.z = cvtpk(sp[4 * 65], sp[5 * 65]); o.w = cvtpk(sp[6 * 65], sp[7 * 65]);
        *(u32x4*)(dst + (size_t)rm(n0 + n) * ldd + coff + k0 + kc) = o; }
    LDS_WAIT(); asm volatile("" ::: "memory");
}
struct RmId { __device__ __forceinline__ int operator()(int n) const { return n; } };
struct RmIn { __device__ __forceinline__ int operator()(int n) const { if (n < 2560 || n >= 3584) return n; const int d = n & 127; return (n & ~127) + 2 * (d & 63) + (d >> 6); } };
struct Rm13 { int half; __device__ __forceinline__ int operator()(int n) const { return (n >> 7) * 256 + half * 128 + (n & 127); } };
template <class RowMap>
__device__ __forceinline__ void transpose_item_i8(const float* W, int ldw, unsigned char* dst, int pitch, const RowMap& rm, LAS float* scr, int k0, int n0, int lane, const float* gain, const float sw, const unsigned* colmax = nullptr) {
    const int rr = lane >> 4, c4 = (lane & 15) * 4;
    f32x4 v[16];
#pragma unroll
    for (int i = 0; i < 16; ++i) v[i] = *(const f32x4*)(W + (size_t)(k0 + 4 * i + rr) * ldw + n0 + c4);
    f32x4 sc = (f32x4){sw, sw, sw, sw};
    if (colmax) {
#pragma unroll
        for (int c = 0; c < 4; ++c) sc[c] = 127.0f / __builtin_bit_cast(float, __hip_atomic_load(colmax + n0 + c4 + c, __ATOMIC_RELAXED, __HIP_MEMORY_SCOPE_AGENT)); }
#pragma unroll
    for (int i = 0; i < 16; ++i) { const int kk = 4 * i + rr; const float gk = gain[k0 + kk]; LAS float* d = scr + kk * 65 + c4;
        d[0] = v[i][0] * gk * sc[0]; d[1] = v[i][1] * gk * sc[1]; d[2] = v[i][2] * gk * sc[2]; d[3] = v[i][3] * gk * sc[3]; }
    LDS_WAIT(); asm volatile("" ::: "memory");
    const int kc = (lane & 7) * 8;
#pragma unroll
    for (int j = 0; j < 8; ++j) { const int n = 8 * j + (lane >> 3); const LAS float* sp = scr + kc * 65 + n;
        u32x2 o; o.x = quant4_i8(sp[0 * 65], sp[1 * 65], sp[2 * 65], sp[3 * 65], 1.0f); o.y = quant4_i8(sp[4 * 65], sp[5 * 65], sp[6 * 65], sp[7 * 65], 1.0f);
        *(u32x2*)(dst + (size_t)rm(n0 + n) * pitch + k0 + kc) = o; }
    LDS_WAIT(); asm volatile("" ::: "memory");
}

__device__ __forceinline__ void wmax_phase(KA a, int vcu, int NGW, const int L) {
    const int tid = opaque_tid(), lane = tid & 63, gw = vcu * NWAVES + __builtin_amdgcn_readfirstlane(tid >> 6);
    unsigned* wm = (unsigned*)(a->ws + WS_CTL) + CW_WMAX;
    constexpr int I_G = (DM / 64) * (DM / 64);
    for (int it = gw; it < 4 * I_G; it += NGW) {
        const int lk = L * 4 + it / I_G, r = it % I_G, k0 = 64 * (r / (DM / 64)), n0 = 64 * (r % (DM / 64)), rr = lane >> 4, c4 = (lane & 15) * 4;
        const float* W = a->w_gate + (size_t)lk * DM * DM; const float* g = a->g_mix + (lk >> 2) * DM;
        f32x4 v[16];
#pragma unroll
        for (int i = 0; i < 16; ++i) v[i] = *(const f32x4*)(W + (size_t)(k0 + 4 * i + rr) * DM + n0 + c4);
        float mx = 0.f;
#pragma unroll
        for (int i = 0; i < 16; ++i) { const float gk = g[k0 + 4 * i + rr];
            mx = fmaxf(mx, fmaxf(fmaxf(fabsf(v[i][0] * gk), fabsf(v[i][1] * gk)), fmaxf(fabsf(v[i][2] * gk), fabsf(v[i][3] * gk)))); }
#pragma unroll
        for (int o = 1; o < 64; o <<= 1) mx = fmaxf(mx, shfl_x(mx, o, lane));
        if (lane == 0) atomicMax(wm + lk, __builtin_bit_cast(unsigned, mx));
    }
    constexpr int I_1 = (DM / 64) * (DFF / 64);
    unsigned* cm = (unsigned*)(a->ws + WS_CTL) + CW_CMAX;
    for (int it = gw; it < 2 * I_1; it += NGW) {
        const int lh = L * 2 + it / I_1, r = it % I_1, l = L, k0 = 64 * (r / (DFF / 64)), n0 = 64 * (r % (DFF / 64)), rr = lane >> 4, c4 = (lane & 15) * 4;
        const float* W = ((lh & 1) ? a->w_ffn3 : a->w_ffn1) + (size_t)l * DM * DFF; const float* g = a->g_ffn + l * DM;
        f32x4 v[16];
#pragma unroll
        for (int i = 0; i < 16; ++i) v[i] = *(const f32x4*)(W + (size_t)(k0 + 4 * i + rr) * DFF + n0 + c4);
        f32x4 mx = (f32x4){0.f, 0.f, 0.f, 0.f};
#pragma unroll
        for (int i = 0; i < 16; ++i) { const float gk = g[k0 + 4 * i + rr];
            mx[0] = fmaxf(mx[0], fabsf(v[i][0] * gk)); mx[1] = fmaxf(mx[1], fabsf(v[i][1] * gk)); mx[2] = fmaxf(mx[2], fabsf(v[i][2] * gk)); mx[3] = fmaxf(mx[3], fabsf(v[i][3] * gk)); }
#pragma unroll
        for (int c = 0; c < 4; ++c) { mx[c] = fmaxf(mx[c], shfl_x(mx[c], 16, lane)); mx[c] = fmaxf(mx[c], shfl_x(mx[c], 32, lane)); }
        if (lane < 16) {
#pragma unroll
            for (int c = 0; c < 4; ++c) atomicMax(cm + (size_t)lh * DFF + n0 + c4 + c, __builtin_bit_cast(unsigned, mx[c])); }
    }
}
__device__ __forceinline__ void prologue_phase(KA a, LAS unsigned char* lds, int vcu, int NGW, const int part, const int L) {
    const int tid = opaque_tid(), lane = tid & 63, wave = __builtin_amdgcn_readfirstlane(tid >> 6), gw = vcu * NWAVES + wave;
    LAS float* scr = (LAS float*)(lds + wave * PRO_SCR);
    constexpr int I_IN = (DM / 64) * (INW / 64), I_G = (DM / 64) * (DM / 64), I_B = (BW / 64) * (DM / 64), I_O = (DM / 64) * (DM / 64), I_1 = (DM / 64) * (DFF / 64), I_2 = (DFF / 64) * (DM / 64);
    constexpr int I_LAYER = I_IN + 4 * I_G + 4 * I_B + I_O + 2 * I_1 + I_2;
    if (part == 1) {
        const int l = L; unsigned char* wl = a->ws + WS_W + (size_t)l * W_LAYER;
        for (int it = gw; it < 4 * I_G + 2 * I_1; it += NGW) { int r = it;
        if (r < 4 * I_G) { const int k = r / I_G; r -= k * I_G; const int nb = DM / 64;
            const float sw = 127.0f / __builtin_bit_cast(float, __hip_atomic_load((const unsigned*)(a->ws + WS_CTL) + CW_WMAX + l * 4 + k, __ATOMIC_RELAXED, __HIP_MEMORY_SCOPE_AGENT));
            transpose_item_i8(a->w_gate + ((size_t)l * 4 + k) * DM * DM, DM, wl + WO_GB + (size_t)k * DM * GBP, GBP, RmId{}, scr, 64 * (r / nb), 64 * (r % nb), lane, a->g_mix + l * DM, sw); continue; } r -= 4 * I_G;
        if (r < 2 * I_1) { const int hf = r / I_1; r -= hf * I_1; const int nb = DFF / 64;
            transpose_item_i8((hf ? a->w_ffn3 : a->w_ffn1) + (size_t)l * DM * DFF, DFF, wl + WO_13, DM, Rm13{hf}, scr, 64 * (r / nb), 64 * (r % nb), lane, a->g_ffn + l * DM, 0.f, (const unsigned*)(a->ws + WS_CTL) + CW_CMAX + (size_t)(2 * l + hf) * DFF); continue; }
        }
        return; }
    if (part == 2) { for (int it = gw; it < DEPTH * I_LAYER; it += NGW) {
        const int l = it / I_LAYER; int r = it - l * I_LAYER;
        unsigned char* wl = a->ws + WS_W + (size_t)l * W_LAYER;
        if (r < I_IN) { const int nb = INW / 64; transpose_item(a->w_in + (size_t)l * DM * INW, INW, (bf16*)(wl + WO_IN), DM, 0, RmIn{}, scr, 64 * (r / nb), 64 * (r % nb), lane, a->g_mix + l * DM); continue; } r -= I_IN;
        if (r < 4 * I_G) continue; r -= 4 * I_G;
        if (r < 4 * I_B) { const int k = r / I_B; r -= k * I_B; const int nb = DM / 64;
            transpose_item(a->w_branch + ((size_t)l * 4 + k) * BW * DM, DM, (bf16*)(wl + WO_GB + (size_t)k * DM * GBP), GBP / 2, 1024, RmId{}, scr, 64 * (r / nb), 64 * (r % nb), lane, nullptr, 1.0f / 255.0f); continue; } r -= 4 * I_B;
        if (r < I_O) { const int nb = DM / 64; transpose_item(a->w_out + (size_t)l * DM * DM, DM, (bf16*)(wl + WO_OUT), DM, 0, RmId{}, scr, 64 * (r / nb), 64 * (r % nb), lane); continue; } r -= I_O;
        if (r < 2 * I_1) continue; r -= 2 * I_1;
        { const int nb = DM / 64; transpose_item(a->w_ffn2 + (size_t)l * DFF * DM, DM, (bf16*)(wl + WO_2), DFF, 0, RmId{}, scr, 64 * (r / nb), 64 * (r % nb), lane); }
    }
    return; }
    { bf16* xb = (bf16*)(a->ws + WS_XB); float* rsa = (float*)(a->ws + WS_RSA); unsigned char* xq = (unsigned char*)a->out; float* xqs = (float*)(a->ws + WS_XQS); float* mxa = (float*)(a->ws + WS_MXA);
      for (int m = gw; m < MTOK; m += NGW) {
          const f32x4* xr = (const f32x4*)(a->x + (size_t)m * DM) + lane; u32x2* o8 = (u32x2*)(xb + (size_t)m * DM) + lane; float sq = 0.f;
          f32x4 v[8];
#pragma unroll
          for (int j = 0; j < 8; ++j) v[j] = xr[64 * j];
#pragma unroll
          for (int j = 0; j < 8; ++j) { u32x2 w; w.x = cvtpk(v[j].x, v[j].y); w.y = cvtpk(v[j].z, v[j].w); o8[64 * j] = w;
              sq += (bf_lo(w.x) * bf_lo(w.x) + bf_hi(w.x) * bf_hi(w.x)) + (bf_lo(w.y) * bf_lo(w.y) + bf_hi(w.y) * bf_hi(w.y)); }
          sq = wave_sum(sq, lane); if (lane < 8) rsa[(size_t)m * 8 + lane] = (lane == 0) ? sq : 0.f;
          float am = 0.f;
#pragma unroll
          for (int j = 0; j < 8; ++j) am = fmaxf(am, fmaxf(fmaxf(fabsf(v[j].x), fabsf(v[j].y)), fmaxf(fabsf(v[j].z), fabsf(v[j].w))));
#pragma unroll
          for (int o = 1; o < 64; o <<= 1) am = fmaxf(am, shfl_x(am, o, lane));
          if (lane < 8) mxa[(size_t)m * 8 + lane] = (lane == 0) ? am : 0.f;
          const float dx = xq_dx(am), sx = __builtin_amdgcn_rcpf(dx); if (lane == 0) xqs[m] = dx;
#pragma unroll
          for (int j = 0; j < 8; ++j) *(unsigned*)(xq + (size_t)m * XQP + (lane + 64 * j) * 4) = quant4_i8(v[j].x, v[j].y, v[j].z, v[j].w, sx); } }
    const int gt = gw * 64 + lane, NGT = NGW * 64;
    bf16* sg = (bf16*)(a->ws + WS_SGUW);
    for (int i = gt; i < DEPTH * 4 * 128 * 128; i += NGT) { const int s = i & 127, t = (i >> 7) & 127; sg[i] = (bf16)(s <= t ? f2bf(a->w_sgu[i]) : 0u); }
    bf16* lw = (bf16*)(a->ws + WS_LRUW);
    for (int i = gt; i < DEPTH * 4 * 4 * 64 * 128; i += NGT) { const int ch = i & 127, n = (i >> 7) & 63, q4 = (i >> 13) & 3, lg = i >> 15;
        const float* src = (n < 32) ? a->w_lru_a : a->w_lru_x; lw[i] = (bf16)f2bf(src[((size_t)lg * 128 + ch) * 128 + q4 * 32 + (n & 31)]); }
    float* spl = (float*)(a->ws + WS_SPLUS);
    for (int i = gt; i < DEPTH * BW; i += NGT) { const float lam = a->lru_lambda[i]; spl[i] = (lam > 15.f) ? expf(-lam) : ((lam < -15.f) ? -lam : log1pf(expf(-lam))); }
    float* cs = (float*)(a->ws + WS_ROPE);
    for (int i = gt; i < SEQ * 64; i += NGT) { const int fi = i & 63, pos = i >> 6;
        const float inv = (float)exp(-(double)fi * (9.210340371976184 / 64.0));
        const double ang = (double)((float)pos * inv);
        const double kk = rint(ang * 0.15915494309189535); const double r = (ang - kk * 6.283185307179586) - kk * 2.4492935982947064e-16;
        const double r2 = r * r; double c = 1.0, s = 1.0, tc = 1.0, ts = 1.0;
#pragma unroll
        for (int n = 1; n <= 14; ++n) { tc *= -r2 / (double)((2 * n - 1) * (2 * n)); ts *= -r2 / (double)((2 * n) * (2 * n + 1)); c += tc; s += ts; }
        cs[2 * i] = (float)c; cs[2 * i + 1] = (float)(s * r); }
}

__device__ __forceinline__ void final_norm_phase(const bf16* xb, const float* rsp, const float* g, float* out, int vcu, int NGW) {
    const int tid = opaque_tid(), lane = tid & 63, gw = vcu * NWAVES + __builtin_amdgcn_readfirstlane(tid >> 6);
    f32x4 gv[8];
#pragma unroll
    for (int j = 0; j < 8; ++j) gv[j] = *((const f32x4*)g + lane + 64 * j);
    for (int m = gw; m < MTOK; m += NGW) {
        const float rstd = pg8::row_rstd(rsp, m);
        const u32x2* xr = (const u32x2*)(xb + (size_t)m * DM) + lane; f32x4* o = (f32x4*)(out + (size_t)m * DM) + lane;
#pragma unroll
        for (int j = 0; j < 8; ++j) { const u32x2 w = xr[64 * j]; o[64 * j] = (f32x4){bf_lo(w.x), bf_hi(w.x), bf_lo(w.y), bf_hi(w.y)} * rstd * gv[j]; }
    }
}

__device__ __forceinline__ void sgu_job(KA a, int l, int job, LAS unsigned char* lds) {
    const int tid = opaque_tid(), lane = tid & 63, wave = __builtin_amdgcn_readfirstlane(tid >> 6);
    const bf16* P = (const bf16*)(a->ws + WS_P); bf16* O = (bf16*)(a->ws + WS_O);
    const int b = job >> 4, n = job & 15; const size_t t0 = (size_t)b * SEQ + n * 128;
    LAS float* rstd = (LAS float*)lds; constexpr int VP = 288, VSZ = 128 * VP;
    { u32x4 wv[16];
#pragma unroll
      for (int i = 0; i < 16; ++i) wv[i] = *(const u32x4*)(P + (t0 + wave * 16 + i) * INW + 512 + lane * 8);
#pragma unroll
      for (int i = 0; i < 16; ++i) { const u32x4 w = wv[i];
          float s = (bf_lo(w.x) * bf_lo(w.x) + bf_hi(w.x) * bf_hi(w.x)) + (bf_lo(w.y) * bf_lo(w.y) + bf_hi(w.y) * bf_hi(w.y)) + (bf_lo(w.z) * bf_lo(w.z) + bf_hi(w.z) * bf_hi(w.z)) + (bf_lo(w.w) * bf_lo(w.w) + bf_hi(w.w) * bf_hi(w.w));
          s = wave_sum(s, lane); if (lane == 0) rstd[wave * 16 + i] = __builtin_amdgcn_rsqf(s * (1.f / BW) + EPS); } }
    const bf16* Wg = (const bf16*)(a->ws + WS_SGUW) + (size_t)l * 4 * 128 * 128;
    const float* gs = a->g_sgu + l * BW; const float* bs = a->b_sgu + l * 128 * 4;
    const int li = lane & 15, G = lane >> 4, c16 = tid & 15;
    u32x4 vr[4];
#pragma unroll
    for (int i = 0; i < 4; ++i) vr[i] = *(const u32x4*)(P + (t0 + (tid >> 4) + 32 * i) * INW + 512 + c16 * 8);
    LDS_BARRIER();
    for (int g = 0; g < 4; ++g) {
        LAS unsigned char* Vl = lds + 1024 + (g & 1) * VSZ;
        { const f32x4 g0 = *(const f32x4*)(gs + g * 128 + c16 * 8), g1 = *(const f32x4*)(gs + g * 128 + c16 * 8 + 4);
#pragma unroll
          for (int i = 0; i < 4; ++i) { const int r = (tid >> 4) + 32 * i; const u32x4 w = vr[i]; const float rs = rstd[r];
              u32x4 o; o.x = cvtpk(bf_lo(w.x) * rs * g0[0], bf_hi(w.x) * rs * g0[1]); o.y = cvtpk(bf_lo(w.y) * rs * g0[2], bf_hi(w.y) * rs * g0[3]);
              o.z = cvtpk(bf_lo(w.z) * rs * g1[0], bf_hi(w.z) * rs * g1[1]); o.w = cvtpk(bf_lo(w.w) * rs * g1[2], bf_hi(w.w) * rs * g1[3]);
              *(LAS u32x4*)(Vl + r * VP + c16 * 16) = o; } }
        if (g + 1 < 4) {
#pragma unroll
            for (int i = 0; i < 4; ++i) vr[i] = *(const u32x4*)(P + (t0 + (tid >> 4) + 32 * i) * INW + 512 + (g + 1) * 128 + c16 * 8); }
        const int t = wave * 16 + li; u32x2 uw[8];
#pragma unroll
        for (int ct = 0; ct < 8; ++ct) uw[ct] = *(const u32x2*)(P + (t0 + t) * INW + g * 128 + ct * 16 + 4 * G);
        const float bb = bs[t * 4 + g];
        LDS_BARRIER();
        f32x4 acc[8];
#pragma unroll
        for (int ct = 0; ct < 8; ++ct) acc[ct] = (f32x4){0.f, 0.f, 0.f, 0.f};
        const int nks = (wave >> 1) + 1;
        for (int ks = 0; ks < nks; ++ks) {
            const bf16x8 wf = *(const bf16x8*)(Wg + ((size_t)g * 128 + wave * 16 + li) * 128 + ks * 32 + G * 8);
#pragma unroll
            for (int ct = 0; ct < 8; ++ct) {
                const LAS unsigned char* p0 = Vl + (ks * 32 + G * 8 + (li >> 2)) * VP + (ct * 16 + 4 * (li & 3)) * 2;
                const s16x4 lo = __builtin_bit_cast(s16x4, __builtin_amdgcn_ds_read_tr16_b64_v4i16((LAS v4i16_t*)p0));
                const s16x4 hi = __builtin_bit_cast(s16x4, __builtin_amdgcn_ds_read_tr16_b64_v4i16((LAS v4i16_t*)(p0 + 4 * VP)));
                const bf16x8 vf = (bf16x8){lo[0], lo[1], lo[2], lo[3], hi[0], hi[1], hi[2], hi[3]};
                acc[ct] = __builtin_amdgcn_mfma_f32_16x16x32_bf16(vf, wf, acc[ct], 0, 0, 0);
            }
        }
#pragma unroll
        for (int ct = 0; ct < 8; ++ct) { const int c = g * 128 + ct * 16 + 4 * G;
            u32x2 o; o.x = cvtpk(bf_lo(uw[ct].x) * (acc[ct][0] + bb), bf_hi(uw[ct].x) * (acc[ct][1] + bb)); o.y = cvtpk(bf_lo(uw[ct].y) * (acc[ct][2] + bb), bf_hi(uw[ct].y) * (acc[ct][3] + bb));
            *(u32x2*)(O + (t0 + t) * DM + c) = o; }
    }
    LDS_BARRIER();
}
__device__ __forceinline__ void sconv_job(KA a, int l, int job) {
    const int tid = opaque_tid();
    const bf16* P = (const bf16*)(a->ws + WS_P); bf16* O = (bf16*)(a->ws + WS_O);
    const int b = job >> 4, n = job & 15, c8 = tid & 63, sg = tid >> 6;
    const float* wc = a->w_sconv + (size_t)l * 3 * BW + c8 * 8;
    float w0[8], w1[8], w2[8];
#pragma unroll
    for (int e = 0; e < 8; ++e) { w0[e] = wc[e]; w1[e] = wc[BW + e]; w2[e] = wc[2 * BW + e]; }
    const bf16* Pb = P + (size_t)b * SEQ * INW + c8 * 8; bf16* Ob = O + (size_t)b * SEQ * DM + 512 + c8 * 8;
    for (int ps = 0; ps < 4; ++ps) {
        const int ts0 = n * 128 + ps * 32 + sg * 4;
        u32x4 cg[6], xc[6], bg[4];
#pragma unroll
        for (int i = 0; i < 6; ++i) { const int tt = ts0 + i - 2; cg[i] = (u32x4){0u, 0u, 0u, 0u}; xc[i] = cg[i];
            if (tt >= 0) { cg[i] = *(const u32x4*)(Pb + (size_t)tt * INW + 1536); xc[i] = *(const u32x4*)(Pb + (size_t)tt * INW + 2048); } }
#pragma unroll
        for (int i = 0; i < 4; ++i) bg[i] = *(const u32x4*)(Pb + (size_t)(ts0 + i) * INW + 1024);
        float pr[6][8];
#pragma unroll
        for (int i = 0; i < 6; ++i) { pr[i][0] = bf_lo(cg[i].x) * bf_lo(xc[i].x); pr[i][1] = bf_hi(cg[i].x) * bf_hi(xc[i].x); pr[i][2] = bf_lo(cg[i].y) * bf_lo(xc[i].y); pr[i][3] = bf_hi(cg[i].y) * bf_hi(xc[i].y);
            pr[i][4] = bf_lo(cg[i].z) * bf_lo(xc[i].z); pr[i][5] = bf_hi(cg[i].z) * bf_hi(xc[i].z); pr[i][6] = bf_lo(cg[i].w) * bf_lo(xc[i].w); pr[i][7] = bf_hi(cg[i].w) * bf_hi(xc[i].w); }
#pragma unroll
        for (int i = 0; i < 4; ++i) { float y[8];
#pragma unroll
            for (int e = 0; e < 8; ++e) y[e] = w0[e] * pr[i][e] + w1[e] * pr[i + 1][e] + w2[e] * pr[i + 2][e];
            u32x4 o; o.x = cvtpk(bf_lo(bg[i].x) * y[0], bf_hi(bg[i].x) * y[1]); o.y = cvtpk(bf_lo(bg[i].y) * y[2], bf_hi(bg[i].y) * y[3]);
            o.z = cvtpk(bf_lo(bg[i].z) * y[4], bf_hi(bg[i].z) * y[5]); o.w = cvtpk(bf_lo(bg[i].w) * y[6], bf_hi(bg[i].w) * y[7]);
            *(u32x4*)(Ob + (size_t)(ts0 + i) * DM) = o; }
    }
}
__device__ __forceinline__ void moba_job(KA a, int job, unsigned char* lds_g) {
    const int tid = opaque_tid();
    const bf16* P = (const bf16*)(a->ws + WS_P); bf16* O = (bf16*)(a->ws + WS_O);
    const int bh = job >> 2, x = job & 3, b = bh >> 2, h = bh & 3, oS = x, oB = 7 - x;
    const bf16* Qb = P + (size_t)b * SEQ * INW + 2560 + h * 128; const bf16* Kb = P + (size_t)b * SEQ * INW + 3072 + h * 128; const bf16* Vb = P + (size_t)b * SEQ * INW + 3584 + h * 128;
    bf16* Ob = O + (size_t)b * SEQ * DM + 1024 + h * 128;
    unsigned* selm = (unsigned*)(lds_g + att::OFF_SEL); float* kmean = (float*)(lds_g + att::OFF_KMEAN); float* part = (float*)(lds_g + att::OFF_PART);
    { const int g = tid >> 4, c = tid & 15;
      for (int j = 0; j < oB; ++j) {
          float s[8];
#pragma unroll
          for (int e = 0; e < 8; ++e) s[e] = 0.f;
#pragma unroll
          for (int i = 0; i < 8; ++i) { const u32x4 w = *(const u32x4*)(Kb + (size_t)(j * 256 + g * 8 + i) * INW + c * 8);
              s[0] += bf_lo(w.x); s[1] += bf_hi(w.x); s[2] += bf_lo(w.y); s[3] += bf_hi(w.y); s[4] += bf_lo(w.z); s[5] += bf_hi(w.z); s[6] += bf_lo(w.w); s[7] += bf_hi(w.w); }
          *(f32x4*)(part + g * 128 + c * 8) = (f32x4){s[0], s[1], s[2], s[3]}; *(f32x4*)(part + g * 128 + c * 8 + 4) = (f32x4){s[4], s[5], s[6], s[7]};
          LDS_BARRIER();
          if (tid < 128) { float t = 0.f;
#pragma unroll 8
              for (int gg = 0; gg < 32; ++gg) t += part[gg * 128 + tid];
              kmean[j * 128 + tid] = t * (1.f / 256.f); }
          LDS_BARRIER();
      } }
    if (tid < 256) selm[tid] = (1u << oS) - 1u;
    { const int qr = tid >> 1, hf = tid & 1; const bf16* qp = Qb + (size_t)(oB * 256 + qr) * INW + hf * 64;
      float q[64];
#pragma unroll
      for (int i = 0; i < 8; ++i) { const u32x4 w = *(const u32x4*)(qp + i * 8);
          q[i * 8 + 0] = bf_lo(w.x); q[i * 8 + 1] = bf_hi(w.x); q[i * 8 + 2] = bf_lo(w.y); q[i * 8 + 3] = bf_hi(w.y); q[i * 8 + 4] = bf_lo(w.z); q[i * 8 + 5] = bf_hi(w.z); q[i * 8 + 6] = bf_lo(w.w); q[i * 8 + 7] = bf_hi(w.w); }
      float v1 = -3e38f, v2 = -3e38f, v3 = -3e38f; int i1 = 0, i2 = 0, i3 = 0;
      for (int j = 0; j < oB; ++j) { const float* km = kmean + j * 128 + hf * 64; float s = 0.f;
#pragma unroll
          for (int d = 0; d < 64; d += 4) { const f32x4 kv = *(const f32x4*)(km + d); s += q[d] * kv[0] + q[d + 1] * kv[1] + q[d + 2] * kv[2] + q[d + 3] * kv[3]; }
          s += shfl_x(s, 1, tid & 63);
          if (s > v1) { v3 = v2; i3 = i2; v2 = v1; i2 = i1; v1 = s; i1 = j; }
          else if (s > v2) { v3 = v2; i3 = i2; v2 = s; i2 = j; }
          else if (s > v3) { v3 = s; i3 = j; } }
      if (hf == 0) selm[256 + qr] = (1u << i1) | (1u << i2) | (1u << i3); }
    LDS_BARRIER();
    const att::Heads HD{Qb, Kb, Vb, Ob};
    const att::BlockRef r0{oS * 256, 0}, r1{oB * 256, 1};
    att::Seam S;
    att::moba_prime(HD, r0, (char*)lds_g, S);
    att::moba_block(HD, r0, r1, (char*)lds_g, S);
    att::moba_block(HD, r1, r1, (char*)lds_g, S);
}
__device__ __forceinline__ void lru_job(KA a, int l, int job, LAS unsigned char* lds) {
    const int tid = opaque_tid(), lane = tid & 63, wave = __builtin_amdgcn_readfirstlane(tid >> 6);
    const bf16* P = (const bf16*)(a->ws + WS_P); bf16* O = (bf16*)(a->ws + WS_O);
    const int b = job >> 4, g = (job >> 2) & 3, q4 = job & 3;
    constexpr int XP = 272, AP = 144;
    LAS unsigned char* XR = lds;
    LAS float* ABbase = (LAS float*)(lds + 34816);
    const int li = lane & 15, G = lane >> 4;
    bf16x8 wf[4][4];
    { const bf16* lw = (const bf16*)(a->ws + WS_LRUW) + ((size_t)((l * 4 + g) * 4 + q4)) * 64 * 128;
#pragma unroll
      for (int nt = 0; nt < 4; ++nt)
#pragma unroll
          for (int ks = 0; ks < 4; ++ks) wf[nt][ks] = *(const bf16x8*)(lw + (nt * 16 + li) * 128 + ks * 32 + G * 8); }
    float ba[2], bx[2], sp[2];
#pragma unroll
    for (int n2 = 0; n2 < 2; ++n2) { const int ch = l * BW + g * 128 + q4 * 32 + n2 * 16 + li; ba[n2] = a->b_lru_a[ch]; bx[n2] = a->b_lru_x[ch]; sp[n2] = ((const float*)(a->ws + WS_SPLUS))[ch]; }
    const int c16 = tid & 15, rg = tid >> 4;
    float cw[4][8], cb[8];
    { const float* wp = a->w_lru_conv + (size_t)l * 4 * BW + g * 128 + c16 * 8; const float* bp = a->b_lru_conv + (size_t)l * BW + g * 128 + c16 * 8;
#pragma unroll
      for (int e = 0; e < 8; ++e) { cw[0][e] = wp[e]; cw[1][e] = wp[BW + e]; cw[2][e] = wp[2 * BW + e]; cw[3][e] = wp[3 * BW + e]; cb[e] = bp[e]; } }
    const bf16* Pb = P + (size_t)b * SEQ * INW;
    const int sg = lane & 15, jc = wave * 4 + (lane >> 4);
    const bf16* Gp = Pb + 4608 + g * 128 + q4 * 32 + jc;
    bf16* Op = O + (size_t)b * SEQ * DM + 1536 + g * 128 + q4 * 32 + jc;
    float carry = 0.f;
    u32x4 raw[7];
#pragma unroll
    for (int i = 0; i < 7; ++i) { const int tt = rg * 4 + i - 3; raw[i] = (u32x4){0u, 0u, 0u, 0u}; if (tt >= 0) raw[i] = *(const u32x4*)(Pb + (size_t)tt * INW + 4096 + g * 128 + c16 * 8); }
    for (int tb = 0; tb < SEQ / 128; ++tb) {
        const int t0 = tb * 128;
        LAS float* Al = ABbase + (tb & 1) * 2 * 32 * AP; LAS float* Bl = Al + 32 * AP;
#pragma unroll
        for (int i = 0; i < 4; ++i) { float y[8];
#pragma unroll
            for (int e = 0; e < 8; ++e) y[e] = cb[e];
#pragma unroll
            for (int kq = 0; kq < 4; ++kq) { const u32x4 w = raw[i + kq];
                y[0] += cw[kq][0] * bf_lo(w.x); y[1] += cw[kq][1] * bf_hi(w.x); y[2] += cw[kq][2] * bf_lo(w.y); y[3] += cw[kq][3] * bf_hi(w.y);
                y[4] += cw[kq][4] * bf_lo(w.z); y[5] += cw[kq][5] * bf_hi(w.z); y[6] += cw[kq][6] * bf_lo(w.w); y[7] += cw[kq][7] * bf_hi(w.w); }
            u32x4 o; o.x = cvtpk(y[0], y[1]); o.y = cvtpk(y[2], y[3]); o.z = cvtpk(y[4], y[5]); o.w = cvtpk(y[6], y[7]);
            *(LAS u32x4*)(XR + (rg * 4 + i) * XP + c16 * 16) = o; }
        if (tb + 1 < SEQ / 128) {
#pragma unroll
            for (int i = 0; i < 7; ++i) raw[i] = *(const u32x4*)(Pb + (size_t)(t0 + 128 + rg * 4 + i - 3) * INW + 4096 + g * 128 + c16 * 8); }
        bf16 gt[8];
#pragma unroll
        for (int i = 0; i < 8; ++i) gt[i] = Gp[(size_t)(t0 + sg * 8 + i) * INW];
        LDS_BARRIER();
        { f32x4 acc[4];
#pragma unroll
          for (int nt = 0; nt < 4; ++nt) acc[nt] = (f32x4){0.f, 0.f, 0.f, 0.f};
#pragma unroll
          for (int ks = 0; ks < 4; ++ks) { const bf16x8 xf = *(const LAS bf16x8*)(XR + (wave * 16 + li) * XP + (ks * 32 + G * 8) * 2);
#pragma unroll
              for (int nt = 0; nt < 4; ++nt) acc[nt] = __builtin_amdgcn_mfma_f32_16x16x32_bf16(xf, wf[nt][ks], acc[nt], 0, 0, 0); }
#pragma unroll
          for (int n2 = 0; n2 < 2; ++n2)
#pragma unroll
              for (int r = 0; r < 4; ++r) { const int t = wave * 16 + G * 4 + r, j = n2 * 16 + li;
                  const float rr = sigmoidf_(acc[n2][r] + ba[n2]), ii = sigmoidf_(acc[2 + n2][r] + bx[n2]);
                  const float la = -8.0f * rr * sp[n2]; const float av = __expf(la); const float x2 = 2.0f * la;
                  const float em = (x2 > -0.25f) ? -x2 * (1.0f + x2 * (0.5f + x2 * (0.16666667f + x2 * (0.041666668f + x2 * (0.0083333338f + x2 * 0.0013888889f))))) : (1.0f - av * av);
                  const float mult = __builtin_amdgcn_sqrtf(em);
                  const float xv = bf2f(*(const LAS bf16*)(XR + t * XP + (q4 * 32 + j) * 2));
                  const int pos = (t & 7) * 16 + (t >> 3);
                  Al[j * AP + pos] = av; Bl[j * AP + pos] = mult * (ii * xv); } }
        LDS_BARRIER();
        { float av[8], bv[8]; float Ac = 1.f, Hc = 0.f;
#pragma unroll
          for (int i = 0; i < 8; ++i) { av[i] = Al[jc * AP + i * 16 + sg]; bv[i] = Bl[jc * AP + i * 16 + sg]; Hc = av[i] * Hc + bv[i]; Ac *= av[i]; }
#pragma unroll
          for (int d = 1; d < 16; d <<= 1) { const float Ap_ = shfl_up16(Ac, d, lane), Hp_ = shfl_up16(Hc, d, lane); if (sg >= d) { Hc = Ac * Hp_ + Hc; Ac = Ac * Ap_; } }
          const float hend = Ac * carry + Hc;
          float h = shfl_up16(hend, 1, lane); if (sg == 0) h = carry;
          carry = shfl_idx(hend, lane | 15);
#pragma unroll
          for (int i = 0; i < 8; ++i) { h = av[i] * h + bv[i]; Op[(size_t)(t0 + sg * 8 + i) * DM] = (bf16)f2bf(gelu_tanh(bf2f(gt[i])) * h); } }
    }
    __syncthreads();
}

__global__ void __launch_bounds__(NTHR, 2) mk_fwd(Args args) {
    extern __shared__ __attribute__((aligned(16))) unsigned char lds_g[];
    LAS unsigned char* lds = (LAS unsigned char*)lds_g;
    volatile LAS unsigned* MISC = (volatile LAS unsigned*)(lds + MISC_OFF);
    const KA ka = (KA)__builtin_amdgcn_kernarg_segment_ptr();
    const int G = gridDim.x, bx = blockIdx.x;
    const int vcu = (G % 8 == 0) ? (bx % 8) * (G / 8) + bx / 8 : bx;
    const int NGW = G * NWAVES;
    if (threadIdx.x < 32) MISC[threadIdx.x] = 0u;
    __syncthreads();
    XcdBarrier bar = xcd_barrier_post((unsigned*)(ka->ws + WS_CTL) + CW_BAR + ka->li * XCD_BAR_WORDS, MISC + 8);
    const int lo = ka->ph_lo, hi = ka->ph_hi;
#ifndef PHSEL
#define PHSEL(k) true
#endif
#if MK_N_LAUNCHES == 1
#define IN(k) (PHSEL(k))
#else
#define IN(k) (PHSEL(k) && lo <= (k) && (k) < hi)
#endif
#define SEAM(k) do { if (IN((k) + 1)) xcd_barrier(bar); } while (0)
#ifndef DUPMASK
#define DUPMASK 0
#endif
#define REPS(j) (((DUPMASK >> (j)) & 1) ? 2 : 1)

    if (IN(0)) for (int rep = 0; rep < REPS(0); ++rep) {
        prologue_phase(opaque_ka(ka), lds, vcu, NGW, 0, 0); wmax_phase(opaque_ka(ka), vcu, NGW, 0); xcd_barrier(bar);
        for (int l = 0; l < DEPTH; ++l) { prologue_phase(opaque_ka(ka), lds, vcu, NGW, 1, l);
            if (l + 1 < DEPTH) { wmax_phase(opaque_ka(ka), vcu, NGW, l + 1); xcd_barrier(bar); } }
        prologue_phase(opaque_ka(ka), lds, vcu, NGW, 2, 0); SEAM(0); }

    for (int l = 0; l < DEPTH; ++l) {
        const int pb = 1 + 6 * l;
        if (IN(pb + 0)) for (int rep = 0; rep < REPS(1); ++rep) {
            const KA a = opaque_ka(ka); unsigned char* ws = a->ws; const unsigned char* wl = ws + WS_W + (size_t)l * W_LAYER;
            typedef pg8::GemmSched<MTOK / 256, INW / 256> Sch; Sch S; S.T.init(G, bx); S.A = (const char*)(ws + WS_XB); S.B = (const char*)(wl + WO_IN); S.tA = (size_t)256 * DM * 2; S.tB = (size_t)256 * DM * 2; S.nt = DM / 64;
            pg8::EpiP E{(bf16*)(ws + WS_P), (const float*)(ws + WS_ROPE), (const float*)(ws + WS_RSA)};
            pg8::gemm_phase<pg8::EpiP, Sch>(lds, DM, DM, S, E);
            SEAM(pb + 0);
        }
        if (IN(pb + 1)) for (int rep = 0; rep < REPS(2); ++rep) {
#ifndef DUP3SEL
#define DUP3SEL 15
#endif
            if (rep == 0 || (DUP3SEL & 1)) for (int job = vcu; job < 256; job += G) moba_job(opaque_ka(ka), job, lds_g);
            if (rep == 0 || (DUP3SEL & 2)) for (int job = vcu; job < 256; job += G) lru_job(opaque_ka(ka), l, job, lds);
            if (rep == 0 || (DUP3SEL & 4)) for (int job = vcu; job < 256; job += G) sgu_job(opaque_ka(ka), l, job, lds);
            if (rep == 0 || (DUP3SEL & 8)) for (int job = vcu; job < 256; job += G) sconv_job(opaque_ka(ka), l, job);
            SEAM(pb + 1);
        }
        if (IN(pb + 2)) for (int rep = 0; rep < REPS(3); ++rep) {
            const KA a = opaque_ka(ka); unsigned char* ws = a->ws; const unsigned char* wl = ws + WS_W + (size_t)l * W_LAYER;
            pg8::GateSched S; S.T.init(G, bx); S.XQ = (const char*)a->out; S.O = (const char*)(ws + WS_O); S.Wgb = (const char*)(wl + WO_GB);
            pg8::EpiGate E{(bf16*)(ws + WS_Y), a->b_gate + (size_t)l * 4 * DM, (char*)(ws + WS_SCR + (size_t)bx * SCR_PER_CU), (const float*)(ws + WS_RSA), (LAS u32x4*)(lds + SST_OFF), (LAS u32x4*)(lds + YST_OFF), (const float*)(ws + WS_XQS), (const unsigned*)(ws + WS_CTL) + CW_WMAX + l * 4, {}};
            pg8::gemm_phase<pg8::EpiGate, pg8::GateSched>(lds, DM, GBP / 2, S, E);
            SEAM(pb + 2);
        }
        if (IN(pb + 3)) {
            const KA a = opaque_ka(ka); unsigned char* ws = a->ws; const unsigned char* wl = ws + WS_W + (size_t)l * W_LAYER;
            typedef pg8::GemmSched<MTOK / 256, DM / 256> Sch; Sch S; S.T.init(G, bx); S.A = (const char*)(ws + WS_Y); S.B = (const char*)(wl + WO_OUT); S.tA = (size_t)256 * DM * 2; S.tB = (size_t)256 * DM * 2; S.nt = DM / 64;
            pg8::EpiResBf E{(bf16*)(ws + WS_XB), (float*)(ws + WS_RSB), (LAS float*)(lds + RED_OFF), (unsigned char*)a->out + 2048, (const float*)(ws + WS_MXA), (float*)(ws + WS_XQS) + MTOK, (float*)(ws + WS_MXB), (LAS float*)(lds + SST_OFF)};
            pg8::gemm_phase<pg8::EpiResBf, Sch>(lds, DM, DM, S, E);
            SEAM(pb + 3);
        }
        if (IN(pb + 4)) for (int rep = 0; rep < REPS(5); ++rep) {
            const KA a = opaque_ka(ka); unsigned char* ws = a->ws; const unsigned char* wl = ws + WS_W + (size_t)l * W_LAYER;
            typedef pg8::GemmSched<MTOK / 256, (2 * DFF) / 256> Sch; Sch S; S.T.init(G, bx); S.A = (const char*)a->out + 2048; S.B = (const char*)(wl + WO_13); S.tA = (size_t)256 * XQP; S.tB = (size_t)256 * DM; S.nt = DM / 128;
            pg8::EpiSwiglu E{(bf16*)(ws + WS_H), (const float*)(ws + WS_RSB), (const float*)(ws + WS_XQS) + MTOK, (const unsigned*)(ws + WS_CTL) + CW_CMAX + (size_t)2 * l * DFF};
            pg8::gemm_phase<pg8::EpiSwiglu, Sch>(lds, XQP / 2, DM / 2, S, E);
            SEAM(pb + 4);
        }
        if (IN(pb + 5)) {
            const KA a = opaque_ka(ka); unsigned char* ws = a->ws; const unsigned char* wl = ws + WS_W + (size_t)l * W_LAYER;
            typedef pg8::GemmSched<MTOK / 256, DM / 256> Sch; Sch S; S.T.init(G, bx); S.A = (const char*)(ws + WS_H); S.B = (const char*)(wl + WO_2); S.tA = (size_t)256 * DFF * 2; S.tB = (size_t)256 * DFF * 2; S.nt = DFF / 64;
            pg8::EpiResBf E{(bf16*)(ws + WS_XB), (float*)(ws + WS_RSA), (LAS float*)(lds + RED_OFF), (l + 1 < DEPTH) ? (unsigned char*)a->out : nullptr, (const float*)(ws + WS_MXB), (float*)(ws + WS_XQS), (float*)(ws + WS_MXA), (LAS float*)(lds + SST_OFF)};
            pg8::gemm_phase<pg8::EpiResBf, Sch>(lds, DFF, DFF, S, E);
            SEAM(pb + 5);
        }
    }
    if (IN(NPHASE - 1)) { const KA a = opaque_ka(ka); unsigned char* ws = a->ws; final_norm_phase((const bf16*)(ws + WS_XB), (const float*)(ws + WS_RSA), a->g_final, a->out, vcu, NGW); }
#undef IN
#undef SEAM
}

extern "C" void kernel_launch(void* const* d_in, const int* in_sizes, int n_in, void* d_out, int out_size, void* d_ws, size_t ws_size, hipStream_t stream) {
    static int grid = 0;
    if (grid == 0) {
        if (n_in != 23 || in_sizes[0] != MTOK * DM || out_size != MTOK * DM || ws_size < WS_END) {
            fprintf(stderr, "kernel_launch: built for 23 inputs, x/out of %d floats, >= %zu bytes of workspace; got n_in %d, in0 %d, out %d, ws %zu; nothing launched\n", MTOK * DM, (size_t)WS_END, n_in, n_in > 0 ? in_sizes[0] : -1, out_size, ws_size);
            grid = -1; return; }
        int dev = 0, cus = 0, per_cu = 0;
        if (hipGetDevice(&dev) != hipSuccess || hipDeviceGetAttribute(&cus, hipDeviceAttributeMultiprocessorCount, dev) != hipSuccess) { fprintf(stderr, "kernel_launch: device query failed\n"); grid = -1; return; }
        if (hipFuncSetAttribute((const void*)mk_fwd, hipFuncAttributeMaxDynamicSharedMemorySize, LDS_BYTES) != hipSuccess) { fprintf(stderr, "kernel_launch: hipFuncSetAttribute failed\n"); grid = -1; return; }
        if (hipOccupancyMaxActiveBlocksPerMultiprocessor(&per_cu, (const void*)mk_fwd, NTHR, LDS_BYTES) != hipSuccess || per_cu < 1)
            fprintf(stderr, "kernel_launch: note: occupancy query reports %d workgroups per CU\n", per_cu);
        (void)hipGetLastError();
        grid = cus;
    }
    if (grid < 0) return;
    if (hipMemsetAsync((char*)d_ws + WS_CTL, 0, CTL_ZERO_BYTES, stream) != hipSuccess) { fprintf(stderr, "kernel_launch: memset failed\n"); return; }
    Args a{};
    a.x = (const float*)d_in[0]; a.g_mix = (const float*)d_in[1]; a.w_in = (const float*)d_in[2]; a.w_sgu = (const float*)d_in[3]; a.b_sgu = (const float*)d_in[4]; a.g_sgu = (const float*)d_in[5];
    a.w_sconv = (const float*)d_in[6]; a.w_lru_conv = (const float*)d_in[7]; a.b_lru_conv = (const float*)d_in[8]; a.w_lru_a = (const float*)d_in[9]; a.b_lru_a = (const float*)d_in[10];
    a.w_lru_x = (const float*)d_in[11]; a.b_lru_x = (const float*)d_in[12]; a.lru_lambda = (const float*)d_in[13]; a.w_gate = (const float*)d_in[14]; a.b_gate = (const float*)d_in[15];
    a.w_branch = (const float*)d_in[16]; a.w_out = (const float*)d_in[17]; a.g_ffn = (const float*)d_in[18]; a.w_ffn1 = (const float*)d_in[19]; a.w_ffn3 = (const float*)d_in[20];
    a.w_ffn2 = (const float*)d_in[21]; a.g_final = (const float*)d_in[22];
    a.out = (float*)d_out; a.ws = (unsigned char*)d_ws; a.pad = 0;
#if MK_N_LAUNCHES == 1
    a.ph_lo = 0; a.ph_hi = NPHASE; a.li = 0;
    hipLaunchKernelGGL(mk_fwd, dim3(grid), dim3(NTHR), LDS_BYTES, stream, a);
#else
    for (int ph = 0; ph < NPHASE; ++ph) { a.ph_lo = ph; a.ph_hi = ph + 1; a.li = ph;
        hipLaunchKernelGGL(mk_fwd, dim3(grid), dim3(NTHR), LDS_BYTES, stream, a); }
#endif
    const hipError_t le = hipPeekAtLastError();
    if (le != hipSuccess) fprintf(stderr, "kernel_launch: launch failed: %s\n", hipGetErrorName(le));
}
```
